# Optimizing an MI355X kernel written in HIP

```python
import jax, jax.numpy as jnp
from jax import lax
import numpy as np

D_MODEL = 1024
BATCH = 8
SEQ = 2048
DEPTH = 2

CHUNK = 64
GROUP_W = 512
N_GROUPS = 3
D_MIX = N_GROUPS * GROUP_W
H_A = 4
DH_A = GROUP_W // H_A
CONV_K = 4
POOL_WINDOWS = (2, 4, 8, 16)
N_POOL = len(POOL_WINDOWS)
DC_B = GROUP_W // N_POOL
H_C = 4
DH_C = GROUP_W // H_C
N_MEM = 256
EPS = 1e-6

_SIZES = (2 * GROUP_W, GROUP_W, GROUP_W, GROUP_W, 2 * H_A, GROUP_W, GROUP_W, GROUP_W, GROUP_W)
N_IN = sum(_SIZES)
_OFFS = tuple(int(v) for v in np.cumsum(_SIZES)[:-1])

kernel_name = "hybrid_mlstm_pool_memattn_block"


def rmsnorm(x, g):
    xf = x.astype(jnp.float32)
    y = xf * lax.rsqrt(jnp.mean(xf * xf, axis=-1, keepdims=True) + EPS)
    return (y * g.astype(jnp.float32)).astype(x.dtype)


def causal_dwconv(x, w, b):
    S = x.shape[1]
    xp = jnp.pad(x, ((0, 0), (CONV_K - 1, 0), (0, 0)))
    return b + sum(xp[:, j:j + S] * w[j] for j in range(CONV_K))


def mlstm_chunkwise(q, k, v, ig, logf):
    B, S, H, D = q.shape
    NC, L = S // CHUNK, CHUNK
    to_c = lambda a: a.reshape(B, NC, L, H, D).transpose(0, 3, 1, 2, 4)
    q, k, v = to_c(q), to_c(k), to_c(v)
    ig = ig.reshape(B, NC, L, H).transpose(0, 3, 1, 2)
    logf = logf.reshape(B, NC, L, H).transpose(0, 3, 1, 2)
    b = jnp.cumsum(logf, axis=-1)
    bL = b[..., -1]
    g = bL[..., None] - b + ig
    gmax = jnp.max(g, axis=-1)
    w = jnp.exp(g - gmax[..., None])
    kv_loc = jnp.einsum('bhcld,bhcle->bhcde', k * w[..., None], v)
    n_loc = jnp.einsum('bhcld,bhcl->bhcd', k, w)

    def step(carry, inp):
        C, n, m = carry
        kv_c, n_c, bL_c, gmax_c = inp
        m_new = jnp.maximum(bL_c + m, gmax_c)
        a = jnp.exp(bL_c + m - m_new)
        bc = jnp.exp(gmax_c - m_new)
        C_new = a[..., None, None] * C + bc[..., None, None] * kv_c
        n_new = a[..., None] * n + bc[..., None] * n_c
        return (C_new, n_new, m_new), (C, n, m)

    init = (jnp.zeros((B, H, D, D), jnp.float32), jnp.zeros((B, H, D), jnp.float32),
            jnp.zeros((B, H), jnp.float32))
    mv = lambda a: jnp.moveaxis(a, 2, 0)
    _, (C_prev, n_prev, m_prev) = lax.scan(step, init, (mv(kv_loc), mv(n_loc), mv(bL), mv(gmax)))
    C_prev = jnp.moveaxis(C_prev, 0, 2)
    n_prev = jnp.moveaxis(n_prev, 0, 2)
    m_prev = jnp.moveaxis(m_prev, 0, 2)

    causal = jnp.tril(jnp.ones((L, L), dtype=bool))
    dmat = jnp.where(causal, b[..., :, None] - b[..., None, :] + ig[..., None, :], -jnp.inf)
    inter = b + m_prev[..., None]
    m_t = jnp.maximum(inter, jnp.max(dmat, axis=-1))
    s = jnp.einsum('bhcld,bhcsd->bhcls', q, k) * jnp.exp(dmat - m_t[..., None])
    a_t = jnp.exp(inter - m_t)
    num = a_t[..., None] * jnp.einsum('bhcld,bhcde->bhcle', q, C_prev) + jnp.einsum('bhcls,bhcse->bhcle', s, v)
    den = a_t * jnp.einsum('bhcld,bhcd->bhcl', q, n_prev) + jnp.sum(s, axis=-1)
    h = num / jnp.maximum(jnp.abs(den), jnp.exp(-m_t))[..., None]
    return h.transpose(0, 2, 3, 1, 4).reshape(B, S, H, D)


def mlstm_branch(qk_raw, v, o, ig, fg, conv_w, conv_b, norm_g):
    B, S, _ = v.shape
    f32 = jnp.float32
    qk = jax.nn.silu(causal_dwconv(qk_raw, conv_w, conv_b))
    q, k = jnp.split(qk, 2, axis=-1)
    q = q.astype(f32).reshape(B, S, H_A, DH_A)
    k = k.astype(f32).reshape(B, S, H_A, DH_A) * (DH_A ** -0.5)
    vh = v.astype(f32).reshape(B, S, H_A, DH_A)
    h = mlstm_chunkwise(q, k, vh, ig.astype(f32), jax.nn.log_sigmoid(fg.astype(f32)))
    h = jax.nn.sigmoid(o.astype(f32)).reshape(B, S, H_A, DH_A) * h
    h = h * lax.rsqrt(jnp.mean(h * h, axis=-1, keepdims=True) + EPS)
    h = h * norm_g.astype(f32).reshape(H_A, DH_A)
    return h.reshape(B, S, GROUP_W).astype(v.dtype)


def pool_branch(u, w, scale):
    B, S, _ = u.shape
    uf = u.astype(jnp.float32).reshape(B, S, N_POOL, DC_B)
    cs = jnp.cumsum(uf, axis=1)
    t1 = jnp.arange(1, S + 1, dtype=jnp.float32)
    pooled = []
    for gi, win in enumerate(POOL_WINDOWS):
        c = cs[:, :, gi]
        lo = jnp.pad(c, ((0, 0), (win, 0), (0, 0)))[:, :S]
        cnt = jnp.minimum(t1, float(win))[None, :, None]
        pooled.append((c - lo) / cnt)
    p = (jnp.stack(pooled, axis=2) - uf).astype(u.dtype)
    y = jnp.einsum('bsgc,gcd->bsgd', p, w).reshape(B, S, GROUP_W)
    return y * scale


def mem_attn_branch(qc, mem, mem_norm_g, w_kv):
    B, S, _ = qc.shape
    mn = rmsnorm(mem, mem_norm_g)
    kv = mn @ w_kv
    km, vm = jnp.split(kv, 2, axis=-1)
    km = km.reshape(B, N_MEM, H_C, DH_C)
    vm = vm.reshape(B, N_MEM, H_C, DH_C)
    q = qc.reshape(B, S, H_C, DH_C)
    s = jnp.einsum('bshd,bmhd->bhsm', q, km).astype(jnp.float32) * (DH_C ** -0.5)
    p = jax.nn.softmax(s, axis=-1).astype(vm.dtype)
    return jnp.einsum('bhsm,bmhd->bshd', p, vm).reshape(B, S, GROUP_W)


def setup_inputs(seed: int = 0) -> dict:
    key = jax.random.key(seed)
    ks = jax.random.split(key, 16)
    nrm = jax.random.normal
    f32 = jnp.float32
    x = nrm(ks[0], (BATCH, SEQ, D_MODEL), f32)
    mem = nrm(ks[1], (BATCH, N_MEM, D_MODEL), f32)
    norm_g = 1.0 + 0.1 * nrm(ks[2], (DEPTH, D_MODEL), f32)
    w_in = nrm(ks[3], (DEPTH, D_MODEL, N_IN), f32) * D_MODEL ** -0.5
    b_i = 0.1 * nrm(ks[4], (DEPTH, H_A), f32)
    b_f = jnp.linspace(3.0, 6.0, H_A, dtype=f32)[None, :] + 0.1 * nrm(ks[5], (DEPTH, H_A), f32)
    b_gates = jnp.concatenate([b_i, b_f], axis=-1)
    conv_w = nrm(ks[6], (DEPTH, CONV_K, 2 * GROUP_W), f32) * CONV_K ** -0.5
    conv_b = 0.02 * nrm(ks[7], (DEPTH, 2 * GROUP_W), f32)
    mlstm_norm_g = 1.0 + 0.1 * nrm(ks[8], (DEPTH, GROUP_W), f32)
    pool_w = nrm(ks[9], (DEPTH, N_POOL, DC_B, DC_B), f32) * DC_B ** -0.5
    pool_scale = 1.0 + 0.1 * nrm(ks[10], (DEPTH, GROUP_W), f32)
    mem_norm_g = 1.0 + 0.1 * nrm(ks[11], (DEPTH, D_MODEL), f32)
    w_mem_kv = nrm(ks[12], (DEPTH, D_MODEL, 2 * GROUP_W), f32) * D_MODEL ** -0.5
    w_out = nrm(ks[13], (DEPTH, D_MIX, D_MODEL), f32) * D_MIX ** -0.5
    final_norm_g = 1.0 + 0.1 * nrm(ks[14], (D_MODEL,), f32)
    return {"x": x, "mem": mem, "norm_g": norm_g, "w_in": w_in, "b_gates": b_gates,
            "conv_w": conv_w, "conv_b": conv_b, "mlstm_norm_g": mlstm_norm_g,
            "pool_w": pool_w, "pool_scale": pool_scale, "mem_norm_g": mem_norm_g,
            "w_mem_kv": w_mem_kv, "w_out": w_out, "final_norm_g": final_norm_g}


def reference(x, mem, norm_g, w_in, b_gates, conv_w, conv_b, mlstm_norm_g, pool_w, pool_scale,
              mem_norm_g, w_mem_kv, w_out, final_norm_g):
    for l in range(DEPTH):
        h = rmsnorm(x, norm_g[l])
        proj = h @ w_in[l]
        qk_raw, v, o, z_a, gates, u, z_b, qc, z_c = jnp.split(proj, _OFFS, axis=-1)
        gates = gates + b_gates[l]
        ig, fg = gates[..., :H_A], gates[..., H_A:]
        y_a = mlstm_branch(qk_raw, v, o, ig, fg, conv_w[l], conv_b[l], mlstm_norm_g[l]) * jax.nn.silu(z_a)
        y_b = pool_branch(u, pool_w[l], pool_scale[l]) * jax.nn.silu(z_b)
        y_c = mem_attn_branch(qc, mem, mem_norm_g[l], w_mem_kv[l]) * jax.nn.silu(z_c)
        x = x + jnp.concatenate([y_a, y_b, y_c], axis=-1) @ w_out[l]
    return rmsnorm(x, final_norm_g)
```

```cpp
#include <hip/hip_runtime.h>
#include <cstdio>
#include <cstdint>

#ifndef MK_N_LAUNCHES
#define MK_N_LAUNCHES 1
#endif

#define DI __device__ __forceinline__
#define LAS __attribute__((address_space(3)))
#define GAS __attribute__((address_space(1)))
typedef unsigned short bf16;
typedef unsigned char uchar;
typedef short bf16x8 __attribute__((ext_vector_type(8)));
typedef short s16x4 __attribute__((ext_vector_type(4)));
typedef float f32x4 __attribute__((ext_vector_type(4)));
typedef float f32x16 __attribute__((ext_vector_type(16)));
typedef unsigned u32x4 __attribute__((ext_vector_type(4)));
typedef unsigned u32x2 __attribute__((ext_vector_type(2)));
typedef float f32x2_t __attribute__((ext_vector_type(2)));
typedef __bf16 bf16x2_t __attribute__((ext_vector_type(2)));

constexpr int BATCH = 8, SEQ = 2048, DM = 1024, T = BATCH * SEQ, NIN = 4616, NMEM = 256, DMIX = 1536;
constexpr int LDP = 4608;
constexpr int CQ = 0, CK = 512, CV = 1024, CO = 1536, CU_ = 2048, CQC = 2560, CZA = 3072, CZB = 3584, CZC = 4096;
constexpr float EPS = 1e-6f, LOG2E = 1.4426950408889634f, KSCALE = 0.08838834764831845f;
constexpr int NPH = 10;

constexpr size_t WS_CTL = 0, CTL_ZERO_BYTES = 1u << 20;
constexpr int ROW_XB = 0, ROW_MEMN = T, ROW_WIN0 = T + 2048, WIN_ROWS = 4864, ROW_WKV0 = ROW_WIN0 + 2 * WIN_ROWS, WKV_ROWS = 1024, POOL_ROWS = ROW_WKV0 + 2 * WKV_ROWS;
constexpr size_t WS_POOL = 1u << 20;
constexpr size_t WS_PROJ = WS_POOL + (size_t)POOL_ROWS * 2048;
constexpr size_t WS_VT = WS_PROJ + (size_t)T * LDP * 2;
constexpr size_t WS_WOUT = WS_VT + (size_t)512 * T * 2;
constexpr size_t WS_KM = WS_WOUT + (size_t)2 * 1024 * 1536 * 2;
constexpr size_t WS_VMT = WS_KM + (size_t)2 * 2048 * 512 * 2;
constexpr size_t WS_KVT = WS_VMT + (size_t)2 * 512 * 2048 * 2;
constexpr size_t WS_NL = WS_KVT + (size_t)256 * 16384 * 2;
constexpr size_t WS_STS = WS_NL + (size_t)256 * 128 * 4;
constexpr size_t WS_SSQ = WS_STS + 4096;
constexpr size_t WS_GATES = WS_SSQ + (size_t)T * 16;
constexpr size_t WS_POOLW = WS_GATES + (size_t)T * 32;
constexpr size_t WS_END = WS_POOLW + (size_t)2 * 4 * 128 * 128 * 2;
static_assert(WS_END <= (size_t)256 * 1024 * 1024, "d_ws map exceeds 256 MiB");
constexpr int CW_TMO = 0, CW_BAR = 4096;

constexpr int L_RK = 0, L_RB = 69632, L_SC = 139264, MISC_OFF = 146432, LDS_BYTES = 147456;
constexpr int PA = 272, PB = 528;
constexpr int OSB = 16896, OSP = 132;

DI unsigned cvtpk(float lo, float hi) { f32x2_t v = {lo, hi}; bf16x2_t b = __builtin_convertvector(v, bf16x2_t); return __builtin_bit_cast(unsigned, b); }
DI u32x4 pack8(const float* f) { u32x4 r; r.x = cvtpk(f[0], f[1]); r.y = cvtpk(f[2], f[3]); r.z = cvtpk(f[4], f[5]); r.w = cvtpk(f[6], f[7]); return r; }
DI float bflo(unsigned u) { return __uint_as_float(u << 16); }
DI float bfhi(unsigned u) { return __uint_as_float(u & 0xffff0000u); }
DI void unpack8(u32x4 v, float* f) { f[0] = bflo(v.x); f[1] = bfhi(v.x); f[2] = bflo(v.y); f[3] = bfhi(v.y); f[4] = bflo(v.z); f[5] = bfhi(v.z); f[6] = bflo(v.w); f[7] = bfhi(v.w); }
DI float ex2(float x) { return __builtin_amdgcn_exp2f(x); }
DI float fexp(float x) { return __builtin_amdgcn_exp2f(x * LOG2E); }
DI float frcp(float x) { return __builtin_amdgcn_rcpf(x); }
DI float sigm(float x) { return frcp(1.f + fexp(-x)); }
DI float silu_f(float x) { return x * sigm(x); }
DI float logsig(float x) { return fminf(x, 0.f) - log1pf(__expf(-fabsf(x))); }
#define MFMA32(a, b, c) __builtin_amdgcn_mfma_f32_32x32x16_bf16((a), (b), (c), 0, 0, 0)

namespace pg8 {
#define PG8_LAS __attribute__((address_space(3)))
typedef unsigned short bf16_t;
constexpr int BM = 256, BK = 64, HALF = 128, HTB = HALF * BK * 2, STAGE_BYTES = 8 * HTB, NXCD = 8, WGM = 8;
__host__ __device__ __forceinline__ int lds_byte(int r, int c) { const int st = (r >> 4) * 2 + (c >> 5), rr = r & 15, cc = c & 31, ob = rr * 64 + cc * 2; return st * 1024 + (ob ^ (((ob >> 9) & 1) << 5)); }
__host__ __device__ __forceinline__ void stage_rc(int b, int& R, int& C) { const int st = b / 1024, sb = b % 1024, swz = sb ^ (((sb >> 9) & 1) << 5); R = (st >> 1) * 16 + swz / 64; C = (st & 1) * 32 + (swz % 64) / 2; }
__host__ __device__ __forceinline__ int perm32(int rho) { const int n = rho >> 4, i = rho & 15; return 8 * (i >> 2) + 4 * n + (i & 3); }

struct Unit { int arow, brow, kind, p0, p1, p2; };
struct Gemm { const bf16_t* A; const bf16_t* Bt; int lda, ldb, K; };

__device__ __forceinline__ void tile_of(int L, int nM, int nN, int& pm, int& pn) {
    const int nwg = nM * nN; int wgid = L; { const int q = nwg / NXCD, r = nwg % NXCD, xcd = wgid % NXCD, off = wgid / NXCD; wgid = (xcd < r ? xcd * (q + 1) : r * (q + 1) + (xcd - r) * q) + off; }
    const int nig = WGM * nN, gid = wgid / nig, fm = gid * WGM, gsz = (nM - fm) < WGM ? (nM - fm) : WGM;
    pm = fm + ((wgid % nig) % gsz); pn = (wgid % nig) / gsz;
}

template <class Epi, class Sched, bool ALIGN_EPI = false, bool SP2 = false>
__device__ __forceinline__ void gemm_phase(PG8_LAS unsigned char* lds, const Gemm g, const Sched& S, const Epi& E) {
    int tid_ = threadIdx.x; asm volatile("" : "+v"(tid_)); const int tid = tid_, wid = __builtin_amdgcn_readfirstlane(tid >> 6), lane = tid & 63, wr = wid >> 2, wc = wid & 3, fr = lane & 15, fq = lane >> 4;
    const int K = g.K, nt = K / BK;
    unsigned voffA[2], voffB[2];
#pragma unroll
    for (int i = 0; i < 2; ++i) { int R, C; stage_rc(tid * 16 + i * 8192, R, C); const int Rb = Epi::PERM ? ((R & ~31) + perm32(R & 31)) : R;
        voffA[i] = (unsigned)(R * g.lda + C) * 2u; voffB[i] = (unsigned)(Rb * g.ldb + C) * 2u; }
    const size_t kstep = (size_t)(BK * 2);
    const size_t hstepA = (size_t)HALF * g.lda * 2, hstepB = (size_t)HALF * g.ldb * 2;
    const unsigned ldsw = (unsigned)wid * 1024u;
    const int aoff = lds_byte(wr * 64 + fr, fq * 8), boff = lds_byte(wc * 32 + fr, fq * 8);
#define PG8_SA(b, h) (((b) * 2 + (h)) * HTB)
#define PG8_SB(b, h) ((4 + (b) * 2 + (h)) * HTB)
#define PG8_STAGE(bufoff, gbase, voff) do { _Pragma("unroll") for (int _i = 0; _i < 2; ++_i) \
        __builtin_amdgcn_global_load_lds((const unsigned*)((const char*)(gbase) + (voff)[_i]), (PG8_LAS unsigned*)(lds + (bufoff) + ldsw + _i * 8192), 16, 0, 0); } while (0)
#define PG8_LDA(dst, b, h) do { _Pragma("unroll") for (int m = 0; m < 4; ++m) _Pragma("unroll") for (int k = 0; k < 2; ++k) dst[m][k] = *(const PG8_LAS bf16x8*)(lds + PG8_SA(b, h) + aoff + m * 2048 + k * 1024); } while (0)
#define PG8_LDB(dst, b, h) do { _Pragma("unroll") for (int n = 0; n < 2; ++n) _Pragma("unroll") for (int k = 0; k < 2; ++k) dst[n][k] = *(const PG8_LAS bf16x8*)(lds + PG8_SB(b, h) + boff + n * 2048 + k * 1024); } while (0)
#define PG8_MMA(ai, bj, At, Bt) do { __builtin_amdgcn_s_setprio(1); _Pragma("unroll") for (int m = 0; m < 4; ++m) _Pragma("unroll") for (int n = 0; n < 2; ++n) _Pragma("unroll") for (int k = 0; k < 2; ++k) \
        acc[ai][bj][m][n] = __builtin_amdgcn_mfma_f32_16x16x32_bf16(Bt[n][k], At[m][k], acc[ai][bj][m][n], 0, 0, 0); __builtin_amdgcn_s_setprio(0); } while (0)
#define PG8_WAIT_V(n) asm volatile("s_waitcnt vmcnt(" #n ")" ::: "memory")
#define PG8_WAIT_L(n) asm volatile("s_waitcnt lgkmcnt(" #n ")" ::: "memory")
#define PG8_BAR __builtin_amdgcn_s_barrier()
#define PG8_SCHED __builtin_amdgcn_sched_barrier(0)
    Unit cur, nxt; int ui = 0;
    if (!S.next(0, cur)) return;
    f32x4 acc[2][2][4][2];
#pragma unroll
    for (int a = 0; a < 2; ++a)
#pragma unroll
        for (int b = 0; b < 2; ++b)
#pragma unroll
            for (int m = 0; m < 4; ++m)
#pragma unroll
                for (int n = 0; n < 2; ++n) acc[a][b][m][n] = (f32x4){0.f, 0.f, 0.f, 0.f};
    bf16x8 At[4][2], B0[2][2], B1[2][2];
    const char* cA = (const char*)g.A + (size_t)cur.arow * g.lda * 2; const char* cB = (const char*)g.Bt + (size_t)cur.brow * g.ldb * 2;
    if constexpr (SP2) {
        PG8_STAGE(PG8_SB(0, 0), cB, voffB); PG8_STAGE(PG8_SB(0, 1), cB + hstepB, voffB); PG8_STAGE(PG8_SA(0, 0), cA, voffA); PG8_STAGE(PG8_SA(0, 1), cA + hstepA, voffA);
        if (wr == 1) PG8_BAR;
        PG8_WAIT_V(2); PG8_BAR;
        PG8_STAGE(PG8_SB(1, 0), cB + kstep, voffB); PG8_STAGE(PG8_SA(1, 0), cA + kstep, voffA); PG8_STAGE(PG8_SB(1, 1), cB + hstepB + kstep, voffB);
        PG8_WAIT_V(6); PG8_BAR;
    } else {
        PG8_STAGE(PG8_SB(0, 0), cB, voffB); PG8_STAGE(PG8_SA(0, 0), cA, voffA); PG8_STAGE(PG8_SB(0, 1), cB + hstepB, voffB); PG8_STAGE(PG8_SA(0, 1), cA + hstepA, voffA);
        if (wr == 1) PG8_BAR;
        PG8_WAIT_V(4); PG8_BAR;
        PG8_STAGE(PG8_SB(1, 0), cB + kstep, voffB); PG8_STAGE(PG8_SA(1, 0), cA + kstep, voffA); PG8_STAGE(PG8_SB(1, 1), cB + hstepB + kstep, voffB);
        PG8_WAIT_V(6); PG8_BAR;
    }
    for (;;) {
        const bool has_next = S.next(ui + 1, nxt);
        const char* nA = has_next ? (const char*)g.A + (size_t)nxt.arow * g.lda * 2 : cA; const char* nB = has_next ? (const char*)g.Bt + (size_t)nxt.brow * g.ldb * 2 : cB;
        for (int t = 0; t < nt; t += 2) {
            const bool last = (t == nt - 2);
            const char* a1 = cA + (size_t)(t + 1) * kstep;
            const char* a2 = last ? nA : cA + (size_t)(t + 2) * kstep; const char* b2 = last ? nB : cB + (size_t)(t + 2) * kstep;
            const char* a3 = a2 + kstep; const char* b3 = b2 + kstep;
            if constexpr (SP2) {
            PG8_LDB(B0, 0, 0); PG8_LDB(B1, 0, 1); PG8_SCHED; PG8_LDA(At, 0, 0); PG8_STAGE(PG8_SA(1, 1), a1 + hstepA, voffA);
            PG8_WAIT_V(8); PG8_WAIT_L(0); PG8_BAR; PG8_MMA(0, 0, At, B0); PG8_MMA(0, 1, At, B1); PG8_BAR; PG8_SCHED;
            PG8_LDA(At, 0, 1); PG8_STAGE(PG8_SB(0, 0), b2, voffB); PG8_STAGE(PG8_SB(0, 1), b2 + hstepB, voffB); PG8_STAGE(PG8_SA(0, 0), a2, voffA);
            PG8_WAIT_V(8); PG8_WAIT_L(0); PG8_BAR; PG8_MMA(1, 0, At, B0); PG8_MMA(1, 1, At, B1); PG8_BAR; PG8_SCHED;
            PG8_LDB(B0, 1, 0); PG8_LDB(B1, 1, 1); PG8_SCHED; PG8_LDA(At, 1, 0); PG8_STAGE(PG8_SA(0, 1), a2 + hstepA, voffA);
            PG8_WAIT_V(8); PG8_WAIT_L(0); PG8_BAR; PG8_MMA(0, 0, At, B0); PG8_MMA(0, 1, At, B1); PG8_BAR; PG8_SCHED;
            PG8_LDA(At, 1, 1); PG8_STAGE(PG8_SB(1, 0), b3, voffB); PG8_STAGE(PG8_SB(1, 1), b3 + hstepB, voffB); PG8_STAGE(PG8_SA(1, 0), a3, voffA);
            PG8_WAIT_V(8); PG8_WAIT_L(0); PG8_BAR; PG8_MMA(1, 0, At, B0); PG8_MMA(1, 1, At, B1); PG8_BAR; PG8_SCHED;
            } else {
            PG8_LDB(B0, 0, 0); PG8_SCHED; PG8_LDA(At, 0, 0); PG8_STAGE(PG8_SA(1, 1), a1 + hstepA, voffA);
            PG8_WAIT_L(8); PG8_BAR; PG8_WAIT_L(0); PG8_MMA(0, 0, At, B0); PG8_BAR; PG8_SCHED;
            PG8_LDB(B1, 0, 1); PG8_STAGE(PG8_SB(0, 0), b2, voffB);
            PG8_BAR; PG8_WAIT_L(0); PG8_MMA(0, 1, At, B1); PG8_BAR;
            PG8_LDA(At, 0, 1); PG8_STAGE(PG8_SA(0, 0), a2, voffA);
            PG8_BAR; PG8_WAIT_L(0); PG8_MMA(1, 0, At, B0); PG8_BAR; PG8_SCHED;
            PG8_STAGE(PG8_SB(0, 1), b2 + hstepB, voffB);
            PG8_WAIT_V(6); PG8_BAR; PG8_MMA(1, 1, At, B1); PG8_BAR;
            PG8_LDB(B0, 1, 0); PG8_SCHED; PG8_LDA(At, 1, 0); PG8_STAGE(PG8_SA(0, 1), a2 + hstepA, voffA);
            PG8_WAIT_L(8); PG8_BAR; PG8_WAIT_L(0); PG8_MMA(0, 0, At, B0); PG8_BAR; PG8_SCHED;
            PG8_LDB(B1, 1, 1); PG8_STAGE(PG8_SB(1, 0), b3, voffB);
            PG8_BAR; PG8_WAIT_L(0); PG8_MMA(0, 1, At, B1); PG8_BAR;
            PG8_LDA(At, 1, 1); PG8_STAGE(PG8_SA(1, 0), a3, voffA);
            PG8_BAR; PG8_WAIT_L(0); PG8_MMA(1, 0, At, B0); PG8_BAR; PG8_SCHED;
            PG8_STAGE(PG8_SB(1, 1), b3 + hstepB, voffB);
            PG8_WAIT_V(6); PG8_BAR; PG8_MMA(1, 1, At, B1); PG8_BAR;
            }
        }
        if constexpr (ALIGN_EPI) { if (wr == 0) PG8_BAR; }
        if constexpr (!Epi::AFTER_DRAIN) { E(acc, cur, wr, wc, fr, fq); }
        if (!has_next) break;
#pragma unroll
        for (int a = 0; a < 2; ++a)
#pragma unroll
            for (int b = 0; b < 2; ++b)
#pragma unroll
                for (int m = 0; m < 4; ++m)
#pragma unroll
                    for (int n = 0; n < 2; ++n) acc[a][b][m][n] = (f32x4){0.f, 0.f, 0.f, 0.f};
        cur = nxt; cA = nA; cB = nB; ++ui;
        if constexpr (ALIGN_EPI) { if (wr == 1) PG8_BAR; }
    }
    PG8_WAIT_V(0);
    if constexpr (!ALIGN_EPI) { if (wr == 0) PG8_BAR; }
    PG8_BAR;
    if constexpr (Epi::AFTER_DRAIN) { E.fused(acc, cur, wr, wc, fr, fq, lds, wid, lane); }
#undef PG8_SA
#undef PG8_SB
#undef PG8_STAGE
#undef PG8_LDA
#undef PG8_LDB
#undef PG8_MMA
#undef PG8_WAIT_V
#undef PG8_WAIT_L
#undef PG8_BAR
#undef PG8_SCHED
}
}

struct G1Order {
    int G, c, layer, with_mem;
    DI bool next(int i, pg8::Unit& u) const {
        int L = i * G + c;
        if (L < 64 * 19) {
            int pm, pn; pg8::tile_of(L, 64, 19, pm, pn);
            const int wrow = ROW_WIN0 + layer * WIN_ROWS + pn * 256, xrow = ROW_XB + pm * 256;
            if (pn == 4 || pn == 5) { u.kind = 1; u.arow = wrow; u.brow = xrow; }
            else { u.kind = (pn == 18) ? 2 : 0; u.arow = xrow; u.brow = wrow; }
            u.p0 = pm; u.p1 = pn; u.p2 = layer; return true;
        }
        L -= 64 * 19;
        if (!with_mem || L >= 64) return false;
        const int l = L >> 5; int r = L & 31;
        if (r < 16) { const int mt = r >> 1, nt = r & 1; u.kind = 3; u.arow = ROW_MEMN + mt * 256; u.brow = ROW_WKV0 + l * WKV_ROWS + nt * 256; u.p0 = mt; u.p1 = nt; u.p2 = l; }
        else { r -= 16; const int nt = r >> 3, mt = r & 7; u.kind = 4; u.arow = ROW_WKV0 + l * WKV_ROWS + 512 + nt * 256; u.brow = ROW_MEMN + mt * 256; u.p0 = nt; u.p1 = mt; u.p2 = l; }
        return true;
    }
};
struct EpiG1 {
    static constexpr bool PERM = true, AFTER_DRAIN = false;
    bf16* proj; bf16* vt; float* gates; const float* ssq; const float* bg; bf16* km; bf16* vmt;
    DI float rstd_of(int row) const { const f32x4 s = *(const f32x4*)(ssq + (size_t)row * 4); return rsqrtf(((s.x + s.y) + (s.z + s.w)) * (1.0f / DM) + EPS); }
    DI void operator()(const f32x4 (&acc)[2][2][4][2], const pg8::Unit& u, int wr, int wc, int fr, int fq) const {
        const int kind = u.kind, rowl = wr * 64 + fr, coll = wc * 32 + 8 * fq;
        if (kind == 0 || kind == 2) {
#pragma unroll
            for (int ai = 0; ai < 2; ++ai)
#pragma unroll
                for (int m = 0; m < 4; ++m) {
                    const int row = u.p0 * 256 + ai * 128 + m * 16 + rowl; const float rs = rstd_of(row);
                    if (kind == 0) {
#pragma unroll
                        for (int bj = 0; bj < 2; ++bj) { const f32x4 v0 = acc[ai][bj][m][0] * rs, v1 = acc[ai][bj][m][1] * rs;
                            u32x4 w; w.x = cvtpk(v0[0], v0[1]); w.y = cvtpk(v0[2], v0[3]); w.z = cvtpk(v1[0], v1[1]); w.w = cvtpk(v1[2], v1[3]);
                            *(u32x4*)(proj + (size_t)row * LDP + u.p1 * 256 + bj * 128 + coll) = w; }
                    } else if (wc == 0 && fq == 0) {
                        const f32x4 b0 = *(const f32x4*)(bg), b1 = *(const f32x4*)(bg + 4);
                        *(f32x4*)(gates + (size_t)row * 8) = acc[ai][0][m][0] * rs + b0; *(f32x4*)(gates + (size_t)row * 8 + 4) = acc[ai][0][m][1] * rs + b1;
                    }
                }
        } else if (kind == 1) {
#pragma unroll
            for (int bj = 0; bj < 2; ++bj) {
                const int tok0 = u.p0 * 256 + bj * 128 + coll; f32x4 r0, r1;
#pragma unroll
                for (int q = 0; q < 4; ++q) { r0[q] = rstd_of(tok0 + q); r1[q] = rstd_of(tok0 + 4 + q); }
#pragma unroll
                for (int ai = 0; ai < 2; ++ai)
#pragma unroll
                    for (int m = 0; m < 4; ++m) { const int n = (u.p1 - 4) * 256 + ai * 128 + m * 16 + rowl; const f32x4 v0 = acc[ai][bj][m][0] * r0, v1 = acc[ai][bj][m][1] * r1;
                        u32x4 w; w.x = cvtpk(v0[0], v0[1]); w.y = cvtpk(v0[2], v0[3]); w.z = cvtpk(v1[0], v1[1]); w.w = cvtpk(v1[2], v1[3]);
                        *(u32x4*)(vt + (size_t)n * T + tok0) = w; }
            }
        } else {
            bf16* base = (kind == 3) ? km + (size_t)u.p2 * 2048 * 512 : vmt + (size_t)u.p2 * 512 * 2048; const int ld = (kind == 3) ? 512 : 2048;
#pragma unroll
            for (int ai = 0; ai < 2; ++ai)
#pragma unroll
                for (int m = 0; m < 4; ++m) { const int row = u.p0 * 256 + ai * 128 + m * 16 + rowl;
#pragma unroll
                    for (int bj = 0; bj < 2; ++bj) { const f32x4 v0 = acc[ai][bj][m][0], v1 = acc[ai][bj][m][1];
                        u32x4 w; w.x = cvtpk(v0[0], v0[1]); w.y = cvtpk(v0[2], v0[3]); w.z = cvtpk(v1[0], v1[1]); w.w = cvtpk(v1[2], v1[3]);
                        *(u32x4*)(base + (size_t)row * ld + u.p1 * 256 + bj * 128 + coll) = w; } }
        }
    }
};
struct G2Order { int G, c; DI bool next(int i, pg8::Unit& u) const { const int L = i * G + c; if (L >= 256) return false; int pm, pn; pg8::tile_of(L, 64, 4, pm, pn); u.kind = 0; u.arow = pm * 256; u.brow = pn * 256; u.p0 = pm; u.p1 = pn; u.p2 = 0; return true; } };
struct EpiG2 {
    static constexpr bool PERM = true, AFTER_DRAIN = true;
    const float* base; float* out; bf16* xb; float* ssq;
    DI void fused(f32x4 (&acc)[2][2][4][2], const pg8::Unit& u, int wr, int wc, int fr, int fq, LAS uchar* lds, int wid, int lane) const {
        LAS float* Pp = (LAS float*)lds;
#pragma unroll
        for (int ai = 0; ai < 2; ++ai)
#pragma unroll
            for (int m = 0; m < 4; ++m) {
                const int rl = ai * 128 + wr * 64 + m * 16 + fr; const size_t roff = (size_t)(u.p0 * 256 + rl) * DM + u.p1 * 256 + wc * 32 + 8 * fq; float ss = 0.f;
#pragma unroll
                for (int bj = 0; bj < 2; ++bj) { const size_t off = roff + bj * 128;
                    const f32x4 v0 = acc[ai][bj][m][0] + *(const f32x4*)(base + off), v1 = acc[ai][bj][m][1] + *(const f32x4*)(base + off + 4);
                    *(f32x4*)(out + off) = v0; *(f32x4*)(out + off + 4) = v1;
                    u32x4 w; w.x = cvtpk(v0[0], v0[1]); w.y = cvtpk(v0[2], v0[3]); w.z = cvtpk(v1[0], v1[1]); w.w = cvtpk(v1[2], v1[3]);
                    *(u32x4*)(xb + off) = w;
                    ss += (v0[0] * v0[0] + v0[1] * v0[1]) + (v0[2] * v0[2] + v0[3] * v0[3]) + (v1[0] * v1[0] + v1[1] * v1[1]) + (v1[2] * v1[2] + v1[3] * v1[3]); }
                ss += __shfl_xor(ss, 16); ss += __shfl_xor(ss, 32);
                if (fq == 0) Pp[rl * 4 + wc] = ss;
                asm volatile("" ::: "memory");
            }
        __syncthreads();
        const int tid = wid * 64 + lane;
        if (tid < 256) { const f32x4 p = *(LAS f32x4*)(Pp + tid * 4); ssq[(size_t)(u.p0 * 256 + tid) * 4 + u.p1] = (p.x + p.y) + (p.z + p.w); }
    }
};

#define XB_TMO      128
#define XB_XCNT(j)  (256  + 64 * (j))
#define XB_XSUB(j)  (1280 + 64 * (j))
#define XB_XGEN(j)  (2304 + 64 * (j))
#define XB_TOP      3328
#define XB_TOPGEN   3392
#define XCD_BAR_WORDS 3456
#define XB_SPIN_CAP (1u << 18)
__device__ __forceinline__ unsigned xb_ld(unsigned* p)              { return __hip_atomic_load(p, __ATOMIC_RELAXED, __HIP_MEMORY_SCOPE_AGENT); }
__device__ __forceinline__ unsigned xb_add(unsigned* p, unsigned v) { return __hip_atomic_fetch_add(p, v, __ATOMIC_RELAXED, __HIP_MEMORY_SCOPE_AGENT); }
__device__ __forceinline__ unsigned xb_xcc_id() { return (unsigned)__builtin_amdgcn_s_getreg((3 << 11) | 20) & 0xFu; }
#define XB_SPIN(cond, bar) do { unsigned _sp = 0; while (cond) { __builtin_amdgcn_s_sleep(1); \
    if ((++_sp & 255u) == 0u) { if (xb_ld(&(bar)[XB_TMO])) break; if (_sp > XB_SPIN_CAP) { atomicAdd(&(bar)[XB_TMO], 1u); break; } } } } while (0)
struct XcdBarrier { unsigned* bar; unsigned x; volatile LAS unsigned* st; };
__device__ __forceinline__ XcdBarrier xcd_barrier_post(unsigned* bar, volatile LAS unsigned* st) {
    XcdBarrier b; b.bar = bar; b.x = xb_xcc_id(); b.st = st;
    if (threadIdx.x == 0) (void)xb_add(&bar[XB_XCNT(b.x)], 1u);
    return b;
}
__device__ __forceinline__ void xcd_barrier_complete(unsigned* bar, unsigned x, unsigned& nloc, unsigned& nx) {
    const unsigned G = gridDim.x * gridDim.y * gridDim.z;
    unsigned sum, cnt, mine, sp = 0u;
    for (;;) {
        sum = 0u; cnt = 0u; mine = 0u;
#pragma unroll
        for (unsigned j = 0; j < 16; ++j) { const unsigned c = xb_ld(&bar[XB_XCNT(j)]); sum += c; cnt += (c > 0u) ? 1u : 0u; mine = (j == x) ? c : mine; }
        if (sum == G) break;
        __builtin_amdgcn_s_sleep(1);
        if ((++sp & 255u) == 0u) { if (xb_ld(&bar[XB_TMO])) break; if (sp > XB_SPIN_CAP) { atomicAdd(&bar[XB_TMO], 1u); break; } }
    }
    nloc = mine > 0u ? mine : 1u; nx = cnt > 0u ? cnt : 1u;
}
__device__ __forceinline__ void xcd_barrier(const XcdBarrier& b) {
    asm volatile("s_waitcnt vmcnt(0)" ::: "memory");
    __syncthreads();
    if (threadIdx.x == 0) {
        unsigned* bar = b.bar;
        __builtin_amdgcn_s_waitcnt(0);
        unsigned nloc = b.st[0], nx = b.st[1];
        if (nloc == 0u) { xcd_barrier_complete(bar, b.x, nloc, nx); b.st[0] = nloc; b.st[1] = nx; }
        const unsigned old = xb_add(&bar[XB_XSUB(b.x)], 1u);
        const unsigned gen = old / nloc;
        if (old + 1u == (gen + 1u) * nloc) {
            __builtin_amdgcn_fence(__ATOMIC_RELEASE, "agent");
            asm volatile("s_waitcnt vmcnt(0)" ::: "memory");
            const unsigned og = xb_add(&bar[XB_TOP], 1u);
            const unsigned tg = og / nx;
            if (og + 1u == (tg + 1u) * nx) xb_add(&bar[XB_TOPGEN], 1u);
            else XB_SPIN(xb_ld(&bar[XB_TOPGEN]) == tg, bar);
            __builtin_amdgcn_fence(__ATOMIC_ACQUIRE, "agent");
            xb_add(&bar[XB_XGEN(b.x)], 1u);
            asm volatile("s_waitcnt vmcnt(0)" ::: "memory");
        } else {
            XB_SPIN(xb_ld(&bar[XB_XGEN(b.x)]) == gen, bar);
            __builtin_amdgcn_fence(__ATOMIC_ACQUIRE, "agent");
            asm volatile("s_waitcnt vmcnt(0)" ::: "memory");
        }
    }
    __syncthreads();
}

struct Args { const float* in[14]; float* out; uchar* ws; int ph_lo, ph_hi, li, pad; };
struct Ctx {
    LAS uchar* lds; int tid, lane, wave, G, vcu;
    const float *x, *mem, *norm_g, *w_in, *b_gates, *conv_w, *conv_b, *mng, *pool_w, *pool_scale, *mem_norm_g, *w_mem_kv, *w_out, *fng;
    float* out; bf16 *pool, *proj, *vt, *wout, *km, *vmt, *kvt, *poolw; float *nl, *sts, *ssq, *gates;
};

DI float wave_sum(float v) {
#pragma unroll
    for (int o = 1; o < 64; o <<= 1) v += __shfl_xor(v, o);
    return v;
}
DI int srccol_win(int n) {
    if (n < 2048) return n;
    if (n < 2560) return 2568 + (n - 2048);
    if (n < 3072) return 3592 + (n - 2560);
    if (n < 3584) return 2048 + (n - 3072);
    if (n < 4096) return 3080 + (n - 3584);
    if (n < 4608) return 4104 + (n - 4096);
    if (n < 4616) return 2560 + (n - 4608);
    return -1;
}
template <bool WINMAP>
DI void tr_item(const float* W, int ldw, const float* gsc, bf16* WT, int K, int k0, int n0, LAS float* scr, int lane) {
    const int nn = n0 + (lane & 31); const int sc = WINMAP ? srccol_win(nn) : nn;
#pragma unroll 8
    for (int i = 0; i < 32; ++i) { const int kk = 2 * i + (lane >> 5); float v = 0.f; if (sc >= 0) { v = W[(size_t)(k0 + kk) * ldw + sc]; if (gsc) v *= gsc[k0 + kk]; } scr[kk * 33 + (lane & 31)] = v; }
    asm volatile("s_waitcnt lgkmcnt(0)" ::: "memory");
    const int c = lane & 7;
#pragma unroll
    for (int j = 0; j < 4; ++j) { const int n = (lane >> 3) + 8 * j; const LAS float* s = scr + (8 * c) * 33 + n;
        u32x4 o; o.x = cvtpk(s[0 * 33], s[1 * 33]); o.y = cvtpk(s[2 * 33], s[3 * 33]); o.z = cvtpk(s[4 * 33], s[5 * 33]); o.w = cvtpk(s[6 * 33], s[7 * 33]);
        *(u32x4*)(WT + (size_t)(n0 + n) * K + k0 + 8 * c) = o; }
    asm volatile("s_waitcnt lgkmcnt(0)" ::: "memory");
}
DI void p0_prologue(const Ctx& F) {
    LAS float* scr = (LAS float*)(F.lds + F.wave * 16384);
    int lane_ = F.lane; asm volatile("" : "+v"(lane_)); const int gw = F.vcu * 8 + F.wave, NGW = F.G * 8, lane = lane_;
    constexpr int I_WIN = 16 * (WIN_ROWS / 32), I_WKV = 16 * 32, I_WOUT = 24 * 32, I_PW = 4 * 8, I_L = I_WIN + I_WKV + I_WOUT + I_PW;
    for (int it = gw; it < 2 * I_L; it += NGW) {
        const int l = it / I_L; int r = it % I_L;
        if (r < I_WIN) { const int kb = r / (WIN_ROWS / 32), nb = r % (WIN_ROWS / 32); tr_item<true>(F.w_in + (size_t)l * DM * NIN, NIN, F.norm_g + l * DM, F.pool + (size_t)(ROW_WIN0 + l * WIN_ROWS) * DM, DM, 64 * kb, 32 * nb, scr, lane); continue; } r -= I_WIN;
        if (r < I_WKV) { const int kb = r / 32, nb = r % 32; tr_item<false>(F.w_mem_kv + (size_t)l * DM * 1024, 1024, F.mem_norm_g + l * DM, F.pool + (size_t)(ROW_WKV0 + l * WKV_ROWS) * DM, DM, 64 * kb, 32 * nb, scr, lane); continue; } r -= I_WKV;
        if (r < I_WOUT) { const int kb = r / 32, nb = r % 32; tr_item<false>(F.w_out + (size_t)l * DMIX * DM, DM, nullptr, F.wout + (size_t)l * DM * DMIX, DMIX, 64 * kb, 32 * nb, scr, lane); continue; } r -= I_WOUT;
        { const int g = r >> 3, kb = (r >> 2) & 1, nb = r & 3; tr_item<false>(F.pool_w + (size_t)(l * 4 + g) * 16384, 128, nullptr, F.poolw + (size_t)(l * 4 + g) * 16384, 128, 64 * kb, 32 * nb, scr, lane); }
    }
    for (int m = gw; m < T + BATCH * NMEM; m += NGW) {
        const bool isx = m < T; const float* src = isx ? F.x + (size_t)m * DM : F.mem + (size_t)(m - T) * DM;
        const f32x4* xr = (const f32x4*)src + lane; f32x4 v[4]; float s = 0.f;
#pragma unroll
        for (int j = 0; j < 4; ++j) { v[j] = xr[64 * j]; s += (v[j].x * v[j].x + v[j].y * v[j].y) + (v[j].z * v[j].z + v[j].w * v[j].w); }
        s = wave_sum(s);
        float sc = 1.f;
        if (isx) { if (lane == 0) *(f32x4*)(F.ssq + (size_t)m * 4) = (f32x4){s, 0.f, 0.f, 0.f}; } else sc = rsqrtf(s * (1.0f / DM) + EPS);
        u32x2* o8 = (u32x2*)(F.pool + (size_t)(isx ? ROW_XB + m : ROW_MEMN + (m - T)) * DM) + lane;
#pragma unroll
        for (int j = 0; j < 4; ++j) { u32x2 w; w.x = cvtpk(v[j].x * sc, v[j].y * sc); w.y = cvtpk(v[j].z * sc, v[j].w * sc); o8[64 * j] = w; }
    }
}

DI int crow(int i, int h) { return (i & 3) + 8 * (i >> 2) + 4 * h; }
DI float wave_scan_add(float v, int lane) {
#pragma unroll
    for (int o = 1; o < 64; o <<= 1) { const float t = __shfl_up(v, o); if (lane >= o) v += t; }
    return v;
}
DI float wave_scan_max(float v, int lane) {
#pragma unroll
    for (int o = 1; o < 64; o <<= 1) { const float t = __shfl_up(v, o); if (lane >= o) v = fmaxf(v, t); }
    return v;
}
DI float block_scan_add(float v, LAS float* tmp, int wid, int lane, float& total) {
    float inc = wave_scan_add(v, lane);
    if (lane == 63 && wid < 4) tmp[wid] = inc;
    __syncthreads();
    const float t0 = tmp[0], t1 = tmp[1], t2 = tmp[2], t3 = tmp[3];
    inc += (wid > 0 ? t0 : 0.f) + (wid > 1 ? t1 : 0.f) + (wid > 2 ? t2 : 0.f);
    total = ((t0 + t1) + t2) + t3;
    __syncthreads();
    return inc;
}
DI float block_scan_max(float v, LAS float* tmp, int wid, int lane, float& total) {
    float inc = wave_scan_max(v, lane);
    if (lane == 63 && wid < 4) tmp[wid] = inc;
    __syncthreads();
    const float t0 = tmp[0], t1 = tmp[1], t2 = tmp[2], t3 = tmp[3];
    if (wid > 0) inc = fmaxf(inc, t0); if (wid > 1) inc = fmaxf(inc, t1); if (wid > 2) inc = fmaxf(inc, t2);
    total = fmaxf(fmaxf(t0, t1), fmaxf(t2, t3));
    __syncthreads();
    return inc;
}
DI void conv_block(const bf16* src, const float* cw, const float* cb, int R0, int tseq0, int tid, float (&o)[8][8]) {
    const int t8 = tid >> 4, d8 = tid & 15;
    u32x4 raw[11];
#pragma unroll
    for (int j = 0; j < 11; ++j) { const int tr = t8 * 8 - 3 + j; raw[j] = (u32x4){0u, 0u, 0u, 0u}; if (tseq0 + tr >= 0) raw[j] = *(const u32x4*)(src + (size_t)(R0 + tr) * LDP + d8 * 8); }
    float w[4][8], bb[8];
#pragma unroll
    for (int j = 0; j < 4; ++j) { const f32x4 a = *(const f32x4*)(cw + j * 1024 + d8 * 8), b = *(const f32x4*)(cw + j * 1024 + d8 * 8 + 4);
        w[j][0] = a.x; w[j][1] = a.y; w[j][2] = a.z; w[j][3] = a.w; w[j][4] = b.x; w[j][5] = b.y; w[j][6] = b.z; w[j][7] = b.w; }
    { const f32x4 a = *(const f32x4*)(cb + d8 * 8), b = *(const f32x4*)(cb + d8 * 8 + 4); bb[0] = a.x; bb[1] = a.y; bb[2] = a.z; bb[3] = a.w; bb[4] = b.x; bb[5] = b.y; bb[6] = b.z; bb[7] = b.w; }
#pragma unroll
    for (int t = 0; t < 8; ++t) {
        float a[8];
#pragma unroll
        for (int i = 0; i < 8; ++i) a[i] = bb[i];
#pragma unroll
        for (int j = 0; j < 4; ++j) { float x[8]; unpack8(raw[t + j], x);
#pragma unroll
            for (int i = 0; i < 8; ++i) a[i] += w[j][i] * x[i]; }
#pragma unroll
        for (int i = 0; i < 8; ++i) o[t][i] = silu_f(a[i]);
    }
}
DI void stage_vt(const bf16* vt, int h, int R0, LAS uchar* dst, int tid) {
    const int e = tid >> 2, part = tid & 3;
    const u32x4* src = (const u32x4*)(vt + (size_t)(h * 128 + e) * T + R0 + part * 64);
    u32x4 v[8];
#pragma unroll
    for (int i = 0; i < 8; ++i) v[i] = src[i];
#pragma unroll
    for (int i = 0; i < 8; ++i) *(LAS u32x4*)(dst + e * PB + part * 128 + i * 16) = v[i];
}
DI void stage_O(const f32x16 (&O)[4], LAS float* OS, int r, int hh) {
#pragma unroll
    for (int dt = 0; dt < 4; ++dt)
#pragma unroll
        for (int i = 0; i < 16; ++i) OS[crow(i, hh) * OSP + 32 * dt + r] = O[dt][i];
}

DI void mlstm_state_unit(const Ctx& F, int l, int unit) {
    const int bh = unit / 7, c = unit % 7, b = bh >> 2, h = bh & 3, R0 = b * SEQ + c * 256;
    int tid_ = F.tid; asm volatile("" : "+v"(tid_)); const int tid = tid_, lane = tid & 63, w = __builtin_amdgcn_readfirstlane(tid >> 6), r = lane & 31, hh = lane >> 5;
    LAS uchar* lds = F.lds; LAS float* SC = (LAS float*)(lds + L_SC); LAS float* WT_ = SC; LAS float* TMP = SC + 1408;
    float ig = 0.f, lf = 0.f;
    if (tid < 256) { const float* gp = F.gates + (size_t)(R0 + tid) * 8; ig = gp[h]; lf = logsig(gp[4 + h]); }
    float bL; const float bt = block_scan_add(lf, TMP, w, lane, bL);
    const float g = (tid < 256) ? (bL - bt + ig) : -INFINITY;
    float gmax; (void)block_scan_max(g, TMP, w, lane, gmax);
    if (tid < 256) WT_[tid] = fexp(g - gmax);
    if (tid == 0) { F.sts[(bh * 8 + c) * 2] = bL; F.sts[(bh * 8 + c) * 2 + 1] = gmax; }
    __syncthreads();
    {
        float o[8][8]; conv_block(F.proj + CK + h * 128, F.conv_w + (size_t)l * 4096 + 512 + h * 128, F.conv_b + l * 1024 + 512 + h * 128, R0, c * 256, tid, o);
        const int t8 = tid >> 4, d8 = tid & 15; float wt[8];
#pragma unroll
        for (int t = 0; t < 8; ++t) wt[t] = WT_[t8 * 8 + t] * KSCALE;
#pragma unroll
        for (int i = 0; i < 8; ++i) { float col[8];
#pragma unroll
            for (int t = 0; t < 8; ++t) col[t] = o[t][i] * wt[t];
            *(LAS u32x4*)(lds + L_RK + (d8 * 8 + i) * PB + t8 * 16) = pack8(col); }
    }
    stage_vt(F.vt, h, R0, lds + L_RB, tid);
    __syncthreads();
    {
        const int et = w >> 1, dt0 = (w & 1) * 2; f32x16 acc2[2];
#pragma unroll
        for (int n = 0; n < 2; ++n)
#pragma unroll
            for (int i = 0; i < 16; ++i) acc2[n][i] = 0.f;
#pragma unroll 4
        for (int ks = 0; ks < 16; ++ks) { const bf16x8 a = *(LAS const bf16x8*)(lds + L_RB + (32 * et + r) * PB + (16 * ks + 8 * hh) * 2);
#pragma unroll
            for (int n = 0; n < 2; ++n) { const bf16x8 bb = *(LAS const bf16x8*)(lds + L_RK + (32 * (dt0 + n) + r) * PB + (16 * ks + 8 * hh) * 2); acc2[n] = MFMA32(a, bb, acc2[n]); } }
        bf16* dst = F.kvt + (size_t)(bh * 8 + c) * 16384;
#pragma unroll
        for (int n = 0; n < 2; ++n)
#pragma unroll
            for (int i = 0; i < 16; ++i) dst[(32 * et + crow(i, hh)) * 128 + 32 * (dt0 + n) + r] = (bf16)(cvtpk(acc2[n][i], 0.f) & 0xffffu);
        const int d = tid >> 2, part = tid & 3; float s = 0.f;
#pragma unroll
        for (int q = 0; q < 8; ++q) { float x[8]; unpack8(*(LAS const u32x4*)(lds + L_RK + d * PB + part * 128 + q * 16), x); s += ((x[0] + x[1]) + (x[2] + x[3])) + ((x[4] + x[5]) + (x[6] + x[7])); }
        s += __shfl_xor(s, 1); s += __shfl_xor(s, 2);
        if (part == 0) F.nl[(bh * 8 + c) * 128 + d] = s;
    }
    __syncthreads();
}

DI void finalize_simple(LAS const float* OS, int lane, float rowscale, const float* colscale, bf16* zrow) {
    const int trow = lane >> 1, half = lane & 1;
#pragma unroll
    for (int q = 0; q < 8; ++q) {
        const int c0 = half * 64 + q * 8; float zz[8], y[8];
        unpack8(*(const u32x4*)(zrow + c0), zz);
        const f32x4 o0 = *(LAS const f32x4*)(OS + trow * OSP + c0), o1 = *(LAS const f32x4*)(OS + trow * OSP + c0 + 4);
        f32x4 s0 = (f32x4){1.f, 1.f, 1.f, 1.f}, s1 = s0; if (colscale) { s0 = *(const f32x4*)(colscale + c0); s1 = *(const f32x4*)(colscale + c0 + 4); }
#pragma unroll
        for (int j = 0; j < 4; ++j) { y[j] = o0[j] * rowscale * s0[j] * silu_f(zz[j]); y[4 + j] = o1[j] * rowscale * s1[j] * silu_f(zz[4 + j]); }
        *(u32x4*)(zrow + c0) = pack8(y);
    }
}

template <int WIN>
DI void pool_ptile(const Ctx& F, int R0, int tseq0, int g, LAS uchar* dst, int tid) {
    const int t8 = tid >> 4, c8 = tid & 15; constexpr int NR = 8 + WIN - 1;
    u32x4 raw[NR];
#pragma unroll
    for (int j = 0; j < NR; ++j) { const int tr = t8 * 8 - (WIN - 1) + j; raw[j] = (u32x4){0u, 0u, 0u, 0u}; if (tseq0 + tr >= 0) raw[j] = *(const u32x4*)(F.proj + (size_t)(R0 + tr) * LDP + CU_ + g * 128 + c8 * 8); }
    float s[8];
#pragma unroll
    for (int i = 0; i < 8; ++i) s[i] = 0.f;
#pragma unroll
    for (int j = 0; j < WIN; ++j) { float x[8]; unpack8(raw[j], x);
#pragma unroll
        for (int i = 0; i < 8; ++i) s[i] += x[i]; }
#pragma unroll
    for (int t = 0; t < 8; ++t) {
        float cur[8]; unpack8(raw[t + WIN - 1], cur);
        const int tq = tseq0 + t8 * 8 + t; const float inv = 1.0f / (float)((tq + 1 < WIN) ? (tq + 1) : WIN);
        float p[8];
#pragma unroll
        for (int i = 0; i < 8; ++i) p[i] = s[i] * inv - cur[i];
        *(LAS u32x4*)(dst + (t8 * 8 + t) * PA + c8 * 16) = pack8(p);
        if (t < 7) { float xo[8], xn[8]; unpack8(raw[t], xo); unpack8(raw[t + WIN], xn);
#pragma unroll
            for (int i = 0; i < 8; ++i) s[i] += xn[i] - xo[i]; }
    }
}
DI void pool_unit(const Ctx& F, int l, int unit) {
    const int g = unit & 3, tt = (unit >> 2) & 7, b = unit >> 5, R0 = b * SEQ + tt * 256;
    int tid_ = F.tid; asm volatile("" : "+v"(tid_)); const int tid = tid_, lane = tid & 63, w = __builtin_amdgcn_readfirstlane(tid >> 6), r = lane & 31, hh = lane >> 5;
    LAS uchar* lds = F.lds;
    if (g == 0) pool_ptile<2>(F, R0, tt * 256, g, lds + L_RK, tid); else if (g == 1) pool_ptile<4>(F, R0, tt * 256, g, lds + L_RK, tid);
    else if (g == 2) pool_ptile<8>(F, R0, tt * 256, g, lds + L_RK, tid); else pool_ptile<16>(F, R0, tt * 256, g, lds + L_RK, tid);
    { const u32x4* src = (const u32x4*)(F.poolw + (size_t)(l * 4 + g) * 16384);
#pragma unroll
      for (int i = 0; i < 4; ++i) { const int id = tid + 512 * i; *(LAS u32x4*)(lds + L_RB + (id >> 4) * PA + (id & 15) * 16) = src[id]; } }
    __syncthreads();
    f32x16 O[4];
#pragma unroll
    for (int dt = 0; dt < 4; ++dt)
#pragma unroll
        for (int i = 0; i < 16; ++i) O[dt][i] = 0.f;
#pragma unroll
    for (int kc = 0; kc < 8; ++kc) { const bf16x8 a = *(LAS const bf16x8*)(lds + L_RK + (32 * w + r) * PA + (16 * kc + 8 * hh) * 2);
#pragma unroll
        for (int dt = 0; dt < 4; ++dt) { const bf16x8 bb = *(LAS const bf16x8*)(lds + L_RB + (32 * dt + r) * PA + (16 * kc + 8 * hh) * 2); O[dt] = MFMA32(a, bb, O[dt]); } }
    __syncthreads();
    LAS float* OS = (LAS float*)(lds + w * OSB);
    stage_O(O, OS, r, hh);
    __syncthreads();
    finalize_simple(OS, lane, 1.0f, F.pool_scale + l * 512 + g * 128, F.proj + (size_t)(R0 + 32 * w + (lane >> 1)) * LDP + CZB + g * 128);
    __syncthreads();
}

DI void attn_unit(const Ctx& F, int l, int unit) {
    const int tt = unit & 7, h = (unit >> 3) & 3, b = unit >> 5, R0 = b * SEQ + tt * 256;
    int tid_ = F.tid; asm volatile("" : "+v"(tid_)); const int tid = tid_, lane = tid & 63, w = __builtin_amdgcn_readfirstlane(tid >> 6), r = lane & 31, hh = lane >> 5;
    LAS uchar* lds = F.lds; LAS float* DEN = (LAS float*)(lds + L_SC) + 1024;
    { const bf16* kmb = F.km + (size_t)l * 2048 * 512 + (size_t)(b * 256) * 512 + h * 128;
#pragma unroll
      for (int i = 0; i < 8; ++i) { const int id = tid + 512 * i, m = id >> 4, c8 = id & 15; *(LAS u32x4*)(lds + L_RK + m * PA + c8 * 16) = *(const u32x4*)(kmb + (size_t)m * 512 + c8 * 8); }
      const bf16* vmb = F.vmt + (size_t)l * 512 * 2048 + (size_t)(h * 128) * 2048 + b * 256;
#pragma unroll
      for (int i = 0; i < 8; ++i) { const int id = tid + 512 * i, d = id >> 5, c = id & 31; *(LAS u32x4*)(lds + L_RB + d * PB + c * 16) = *(const u32x4*)(vmb + (size_t)d * 2048 + c * 8); } }
    bf16x8 qf[8];
    { const bf16* qrow = F.proj + (size_t)(R0 + 32 * w + r) * LDP + CQC + h * 128 + 8 * hh;
#pragma unroll
      for (int kd = 0; kd < 8; ++kd) qf[kd] = *(const bf16x8*)(qrow + 16 * kd); }
    __syncthreads();
    f32x16 X[8];
#pragma unroll
    for (int mt = 0; mt < 8; ++mt) {
#pragma unroll
        for (int i = 0; i < 16; ++i) X[mt][i] = 0.f;
#pragma unroll
        for (int kd = 0; kd < 8; ++kd) { const bf16x8 a = *(LAS const bf16x8*)(lds + L_RK + (32 * mt + r) * PA + (16 * kd + 8 * hh) * 2); X[mt] = MFMA32(a, qf[kd], X[mt]); }
    }
    float mx = -INFINITY;
#pragma unroll
    for (int mt = 0; mt < 8; ++mt)
#pragma unroll
        for (int i = 0; i < 16; ++i) mx = fmaxf(mx, X[mt][i]);
    mx = fmaxf(mx, __shfl_xor(mx, 32));
    const float sc2 = KSCALE * LOG2E, mb = mx * sc2; float lsum = 0.f;
    bf16x8 pa[8][2];
#pragma unroll
    for (int mt = 0; mt < 8; ++mt) { float p[16];
#pragma unroll
        for (int i = 0; i < 16; ++i) { p[i] = ex2(X[mt][i] * sc2 - mb); lsum += p[i]; }
        pa[mt][0] = __builtin_bit_cast(bf16x8, pack8(p)); pa[mt][1] = __builtin_bit_cast(bf16x8, pack8(p + 8)); }
    lsum += __shfl_xor(lsum, 32);
    f32x16 O[4];
#pragma unroll
    for (int dt = 0; dt < 4; ++dt)
#pragma unroll
        for (int i = 0; i < 16; ++i) O[dt][i] = 0.f;
#pragma unroll
    for (int mt = 0; mt < 8; ++mt)
#pragma unroll
        for (int s = 0; s < 2; ++s)
#pragma unroll
            for (int dt = 0; dt < 4; ++dt) {
                const LAS uchar* vp = lds + L_RB + (32 * dt + r) * PB + (32 * mt + 16 * s + 4 * hh) * 2;
                const s16x4 lo = *(LAS const s16x4*)vp, hi = *(LAS const s16x4*)(vp + 16);
                O[dt] = MFMA32(pa[mt][s], __builtin_shufflevector(lo, hi, 0, 1, 2, 3, 4, 5, 6, 7), O[dt]); }
    if (hh == 0) DEN[32 * w + r] = frcp(lsum);
    __syncthreads();
    LAS float* OS = (LAS float*)(lds + w * OSB);
    stage_O(O, OS, r, hh);
    __syncthreads();
    finalize_simple(OS, lane, DEN[32 * w + (lane >> 1)], nullptr, F.proj + (size_t)(R0 + 32 * w + (lane >> 1)) * LDP + CZC + h * 128);
    __syncthreads();
}

DI void mlstm_out_unit(const Ctx& F, int l, int unit) {
    const int bh = unit >> 3, c = unit & 7, b = bh >> 2, h = bh & 3, R0 = b * SEQ + c * 256;
    int tid_ = F.tid; asm volatile("" : "+v"(tid_)); const int tid = tid_, lane = tid & 63, w = __builtin_amdgcn_readfirstlane(tid >> 6), r = lane & 31, hh = lane >> 5;
    LAS uchar* lds = F.lds; LAS float* SC = (LAS float*)(lds + L_SC);
    LAS float *GS2 = SC, *R2 = SC + 256, *AT = SC + 512, *EM = SC + 768, *DEN = SC + 1024, *NP = SC + 1280, *TMP = SC + 1408;
    float ig = 0.f, lf = 0.f;
    if (tid < 256) { const float* gp = F.gates + (size_t)(R0 + tid) * 8; ig = gp[h]; lf = logsig(gp[4 + h]); }
    float btot; const float bt = block_scan_add(lf, TMP, w, lane, btot);
    const float gs = (tid < 256) ? (ig - bt) : -INFINITY;
    float coef[7]; float mprev = -INFINITY;
    { float lc[7]; float acc = 0.f;
#pragma unroll
      for (int cp = 6; cp >= 0; --cp) { lc[cp] = -INFINITY; if (cp < c) { const float bl = F.sts[(bh * 8 + cp) * 2], gm = F.sts[(bh * 8 + cp) * 2 + 1]; lc[cp] = gm + acc; acc += bl; mprev = fmaxf(mprev, lc[cp]); } }
#pragma unroll
      for (int cp = 0; cp < 7; ++cp) coef[cp] = (cp < c) ? fexp(lc[cp] - mprev) : 0.f; }
    float cmt; const float cm = block_scan_max(gs, TMP, w, lane, cmt);
    if (tid < 256) { const float rt = fmaxf(mprev, cm); GS2[tid] = gs * LOG2E; R2[tid] = rt * LOG2E; AT[tid] = (c > 0) ? fexp(mprev - rt) : 0.f; EM[tid] = fexp(-(bt + rt)); }
    { float a[4][8];
#pragma unroll
      for (int i = 0; i < 4; ++i)
#pragma unroll
          for (int j = 0; j < 8; ++j) a[i][j] = 0.f;
#pragma unroll
      for (int cp = 0; cp < 7; ++cp) if (cp < c) { const u32x4* sp = (const u32x4*)(F.kvt + (size_t)(bh * 8 + cp) * 16384); const float cf = coef[cp];
#pragma unroll
          for (int i = 0; i < 4; ++i) { float x[8]; unpack8(sp[tid + 512 * i], x);
#pragma unroll
              for (int j = 0; j < 8; ++j) a[i][j] += cf * x[j]; } }
#pragma unroll
      for (int i = 0; i < 4; ++i) { const int idx = (tid + 512 * i) * 8; *(LAS u32x4*)(lds + L_RB + (idx >> 7) * PA + (idx & 127) * 2) = pack8(a[i]); }
      if (tid < 128) { float s = 0.f;
#pragma unroll
          for (int cp = 0; cp < 7; ++cp) if (cp < c) s += coef[cp] * F.nl[(bh * 8 + cp) * 128 + tid];
          NP[tid] = s; } }
    { float o[8][8]; conv_block(F.proj + CQ + h * 128, F.conv_w + (size_t)l * 4096 + h * 128, F.conv_b + l * 1024 + h * 128, R0, c * 256, tid, o);
      const int t8 = tid >> 4, d8 = tid & 15;
#pragma unroll
      for (int t = 0; t < 8; ++t) *(LAS u32x4*)(lds + L_RK + (t8 * 8 + t) * PA + d8 * 16) = pack8(o[t]); }
    __syncthreads();
    bf16x8 qf[8]; float qn = 0.f;
#pragma unroll
    for (int kd = 0; kd < 8; ++kd) { qf[kd] = *(LAS const bf16x8*)(lds + L_RK + (32 * w + r) * PA + (16 * kd + 8 * hh) * 2);
        float x[8]; unpack8(__builtin_bit_cast(u32x4, qf[kd]), x); const f32x4 n0 = *(LAS const f32x4*)(NP + 16 * kd + 8 * hh), n1 = *(LAS const f32x4*)(NP + 16 * kd + 8 * hh + 4);
        qn += (x[0] * n0[0] + x[1] * n0[1]) + (x[2] * n0[2] + x[3] * n0[3]) + (x[4] * n1[0] + x[5] * n1[1]) + (x[6] * n1[2] + x[7] * n1[3]); }
    qn += __shfl_xor(qn, 32);
    f32x16 O[4];
#pragma unroll
    for (int et = 0; et < 4; ++et)
#pragma unroll
        for (int i = 0; i < 16; ++i) O[et][i] = 0.f;
    if (c > 0) {
#pragma unroll
        for (int kd = 0; kd < 8; ++kd)
#pragma unroll
            for (int et = 0; et < 4; ++et) { const bf16x8 cb = *(LAS const bf16x8*)(lds + L_RB + (32 * et + r) * PA + (16 * kd + 8 * hh) * 2); O[et] = MFMA32(qf[kd], cb, O[et]); }
#pragma unroll
        for (int g = 0; g < 4; ++g) { const f32x4 av = *(LAS const f32x4*)(AT + 32 * w + 8 * g + 4 * hh);
#pragma unroll
            for (int et = 0; et < 4; ++et)
#pragma unroll
                for (int j = 0; j < 4; ++j) O[et][4 * g + j] *= av[j]; }
    }
    __syncthreads();
    { float o[8][8]; conv_block(F.proj + CK + h * 128, F.conv_w + (size_t)l * 4096 + 512 + h * 128, F.conv_b + l * 1024 + 512 + h * 128, R0, c * 256, tid, o);
      const int t8 = tid >> 4, d8 = tid & 15;
#pragma unroll
      for (int t = 0; t < 8; ++t) { float kk[8];
#pragma unroll
          for (int i = 0; i < 8; ++i) kk[i] = o[t][i] * KSCALE;
          *(LAS u32x4*)(lds + L_RK + (t8 * 8 + t) * PA + d8 * 16) = pack8(kk); } }
    stage_vt(F.vt, h, R0, lds + L_RB, tid);
    __syncthreads();
    const float r2 = R2[32 * w + r]; float den = 0.f;
    for (int j = 0; j <= w; ++j) {
        const int s0 = 32 * j; f32x16 X;
#pragma unroll
        for (int i = 0; i < 16; ++i) X[i] = 0.f;
#pragma unroll
        for (int kd = 0; kd < 8; ++kd) { const bf16x8 a = *(LAS const bf16x8*)(lds + L_RK + (s0 + r) * PA + (16 * kd + 8 * hh) * 2); X = MFMA32(a, qf[kd], X); }
        float p[16];
#pragma unroll
        for (int g = 0; g < 4; ++g) { const f32x4 gv = *(LAS const f32x4*)(GS2 + s0 + 8 * g + 4 * hh);
#pragma unroll
            for (int jj = 0; jj < 4; ++jj) { float val = ex2(gv[jj] - r2) * X[4 * g + jj]; if (j == w && (8 * g + 4 * hh + jj) > r) val = 0.f; p[4 * g + jj] = val; den += val; } }
        const bf16x8 pa0 = __builtin_bit_cast(bf16x8, pack8(p)), pa1 = __builtin_bit_cast(bf16x8, pack8(p + 8));
#pragma unroll
        for (int s = 0; s < 2; ++s)
#pragma unroll
            for (int et = 0; et < 4; ++et) {
                const LAS uchar* vp = lds + L_RB + (32 * et + r) * PB + (s0 + 16 * s + 4 * hh) * 2;
                const s16x4 lo = *(LAS const s16x4*)vp, hi = *(LAS const s16x4*)(vp + 16);
                O[et] = MFMA32(s ? pa1 : pa0, __builtin_shufflevector(lo, hi, 0, 1, 2, 3, 4, 5, 6, 7), O[et]); }
    }
    den += __shfl_xor(den, 32);
    if (hh == 0) { const int t = 32 * w + r; const float dt_ = AT[t] * qn + den; DEN[t] = frcp(fmaxf(fabsf(dt_), EM[t])); }
    __syncthreads();
    LAS float* OS = (LAS float*)(lds + w * OSB);
    stage_O(O, OS, r, hh);
    __syncthreads();
    {
        const int trow = lane >> 1, half = lane & 1, t = 32 * w + trow; const float inv = DEN[t];
        bf16* prow = F.proj + (size_t)(R0 + t) * LDP; float hv[64]; float ss = 0.f;
#pragma unroll
        for (int q = 0; q < 8; ++q) { const int c0 = half * 64 + q * 8; float og[8]; unpack8(*(const u32x4*)(prow + CO + h * 128 + c0), og);
            const f32x4 o0 = *(LAS const f32x4*)(OS + trow * OSP + c0), o1 = *(LAS const f32x4*)(OS + trow * OSP + c0 + 4);
#pragma unroll
            for (int j = 0; j < 4; ++j) { const float v0 = o0[j] * inv * sigm(og[j]), v1 = o1[j] * inv * sigm(og[4 + j]); hv[q * 8 + j] = v0; hv[q * 8 + 4 + j] = v1; ss += v0 * v0 + v1 * v1; } }
        ss += __shfl_xor(ss, 1);
        const float rn = rsqrtf(ss * (1.0f / 128.0f) + EPS); const float* ng = F.mng + l * 512 + h * 128;
#pragma unroll
        for (int q = 0; q < 8; ++q) { const int c0 = half * 64 + q * 8; float zz[8], y[8]; unpack8(*(const u32x4*)(prow + CZA + h * 128 + c0), zz);
            const f32x4 g0 = *(const f32x4*)(ng + c0), g1 = *(const f32x4*)(ng + c0 + 4);
#pragma unroll
            for (int j = 0; j < 4; ++j) { y[j] = hv[q * 8 + j] * rn * g0[j] * silu_f(zz[j]); y[4 + j] = hv[q * 8 + 4 + j] * rn * g1[j] * silu_f(zz[4 + j]); }
            *(u32x4*)(prow + CZA + h * 128 + c0) = pack8(y); }
    }
    __syncthreads();
}

DI void final_norm(const Ctx& F) {
    int lane_ = F.lane; asm volatile("" : "+v"(lane_)); const int gw = F.vcu * 8 + F.wave, NGW = F.G * 8, lane = lane_;
    f32x4 g[4];
#pragma unroll
    for (int j = 0; j < 4; ++j) g[j] = ((const f32x4*)F.fng)[lane + 64 * j];
    for (int m = gw; m < T; m += NGW) {
        const f32x4 s = *(const f32x4*)(F.ssq + (size_t)m * 4); const float rs = rsqrtf(((s.x + s.y) + (s.z + s.w)) * (1.0f / DM) + EPS);
        f32x4* xr = (f32x4*)(F.out + (size_t)m * DM) + lane;
#pragma unroll
        for (int j = 0; j < 4; ++j) xr[64 * j] = xr[64 * j] * rs * g[j];
    }
}

__global__ void __launch_bounds__(512, 2) hybrid_fwd(Args args) {
    extern __shared__ __attribute__((aligned(16))) unsigned char lds_raw[];
    Ctx F;
    F.lds = (LAS uchar*)lds_raw; F.tid = threadIdx.x; F.lane = F.tid & 63; F.wave = __builtin_amdgcn_readfirstlane(F.tid >> 6);
    F.G = gridDim.x; { const int bx = blockIdx.x; F.vcu = (F.G % 8 == 0) ? (bx % 8) * (F.G / 8) + bx / 8 : bx; }
    uchar* ws = args.ws;
    F.x = args.in[0]; F.mem = args.in[1]; F.norm_g = args.in[2]; F.w_in = args.in[3]; F.b_gates = args.in[4]; F.conv_w = args.in[5]; F.conv_b = args.in[6]; F.mng = args.in[7];
    F.pool_w = args.in[8]; F.pool_scale = args.in[9]; F.mem_norm_g = args.in[10]; F.w_mem_kv = args.in[11]; F.w_out = args.in[12]; F.fng = args.in[13]; F.out = args.out;
    F.pool = (bf16*)(ws + WS_POOL); F.proj = (bf16*)(ws + WS_PROJ); F.vt = (bf16*)(ws + WS_VT); F.wout = (bf16*)(ws + WS_WOUT); F.km = (bf16*)(ws + WS_KM); F.vmt = (bf16*)(ws + WS_VMT);
    F.kvt = (bf16*)(ws + WS_KVT); F.poolw = (bf16*)(ws + WS_POOLW); F.nl = (float*)(ws + WS_NL); F.sts = (float*)(ws + WS_STS); F.ssq = (float*)(ws + WS_SSQ); F.gates = (float*)(ws + WS_GATES);
    volatile LAS unsigned* MISC = (volatile LAS unsigned*)(F.lds + MISC_OFF);
    for (int u = F.tid; u < (LDS_BYTES - MISC_OFF) / 4; u += 512) MISC[u] = 0u;
    __syncthreads();
    unsigned* ctl = (unsigned*)(ws + WS_CTL);
    XcdBarrier bar; bar.bar = ctl + CW_BAR; bar.x = 0; bar.st = nullptr;
    if (MK_N_LAUNCHES == 1) bar = xcd_barrier_post(ctl + CW_BAR, MISC + 8);
    const int lo = args.ph_lo, hi = args.ph_hi;
#define IN(k) (lo <= (k) && (k) < hi)
#define SEAM(k) do { if (IN(k) && IN((k) + 1)) xcd_barrier(bar); } while (0)

    #ifndef SKIP_P0
    if (IN(0)) { p0_prologue(F); }
#endif
    SEAM(0);
#pragma unroll 1
    for (int l = 0; l < 2; ++l) {
        const int pb = 1 + 4 * l;
        if (IN(pb)) {
            pg8::Gemm g{F.pool, F.pool, DM, DM, DM}; G1Order S{F.G, (int)blockIdx.x, l, l == 0 ? 1 : 0};
            EpiG1 E{F.proj, F.vt, F.gates, F.ssq, F.b_gates + l * 8, F.km, F.vmt};
#ifndef SKIP_G1
            pg8::gemm_phase<EpiG1, G1Order, true, true>(F.lds, g, S, E);
#endif
        } SEAM(pb);
        if (IN(pb + 1)) {
            const int u = (int)blockIdx.x;
#ifndef SKIP_ST
            for (int i = u; i < 224; i += F.G) mlstm_state_unit(F, l, i);
#endif
#ifndef SKIP_PL
            for (int i = u; i < 256; i += F.G) pool_unit(F, l, i);
#endif
#ifndef SKIP_AT
            for (int i = u; i < 256; i += F.G) attn_unit(F, l, i);
#endif
        } SEAM(pb + 1);
        if (IN(pb + 2)) {
#ifndef SKIP_MO
            for (int i = (int)blockIdx.x; i < 256; i += F.G) mlstm_out_unit(F, l, i);
#endif
        } SEAM(pb + 2);
        if (IN(pb + 3)) {
            pg8::Gemm g{F.proj + CZA, F.wout + (size_t)l * DM * DMIX, LDP, DMIX, DMIX}; G2Order S{F.G, (int)blockIdx.x};
            EpiG2 E{l == 0 ? F.x : F.out, F.out, F.pool + (size_t)ROW_XB * DM, F.ssq};
#ifndef SKIP_G2
            pg8::gemm_phase<EpiG2, G2Order, false, true>(F.lds, g, S, E);
#endif
        } SEAM(pb + 3);
    }
#ifndef SKIP_FN
    if (IN(9)) final_norm(F);
#endif
#undef IN
#undef SEAM
}

extern "C" void kernel_launch(void* const* d_in, const int* in_sizes, int n_in, void* d_out, int out_size, void* d_ws, size_t ws_size, hipStream_t stream) {
    static int grid = 0;
    if (grid == 0) {
        if (n_in != 14 || in_sizes[0] != T * DM || out_size != T * DM || ws_size < WS_END) { fprintf(stderr, "kernel_launch: unexpected shapes (n_in %d, in0 %d, out %d, ws %zu); nothing launched\n", n_in, n_in > 0 ? in_sizes[0] : -1, out_size, ws_size); grid = -1; return; }
        int dev = 0, cus = 0;
        if (hipGetDevice(&dev) != hipSuccess || hipDeviceGetAttribute(&cus, hipDeviceAttributeMultiprocessorCount, dev) != hipSuccess) { grid = -1; return; }
        if (hipFuncSetAttribute((const void*)hybrid_fwd, hipFuncAttributeMaxDynamicSharedMemorySize, LDS_BYTES) != hipSuccess) { fprintf(stderr, "kernel_launch: hipFuncSetAttribute failed\n"); grid = -1; return; }
        int per_cu = 0;
        if (hipOccupancyMaxActiveBlocksPerMultiprocessor(&per_cu, (const void*)hybrid_fwd, 512, LDS_BYTES) != hipSuccess || per_cu < 1) fprintf(stderr, "kernel_launch: occupancy query reports %d blocks per CU\n", per_cu);
        (void)hipGetLastError();
        grid = cus;
    }
    if (grid < 0) return;
    if (hipMemsetAsync((char*)d_ws + WS_CTL, 0, CTL_ZERO_BYTES, stream) != hipSuccess) return;
    Args a{};
    for (int i = 0; i < 14; ++i) a.in[i] = (const float*)d_in[i];
    a.out = (float*)d_out; a.ws = (uchar*)d_ws;
    for (int li = 0; li < MK_N_LAUNCHES; ++li) {
        if (MK_N_LAUNCHES == 1) { a.ph_lo = 0; a.ph_hi = NPH; } else { a.ph_lo = li * NPH / MK_N_LAUNCHES; a.ph_hi = (li + 1) * NPH / MK_N_LAUNCHES; }
        a.li = li;
        hipLaunchKernelGGL(hybrid_fwd, dim3(grid), dim3(512), LDS_BYTES, stream, a);
        const hipError_t le = hipPeekAtLastError();
        if (le != hipSuccess) { fprintf(stderr, "kernel_launch: launch %d failed: %s\n", li, hipGetErrorName(le)); break; }
    }
}
```

```cpp
#include <hip/hip_runtime.h>
#include <cstdio>
#include <cstdint>

#ifndef MK_N_LAUNCHES
#define MK_N_LAUNCHES 1
#endif
#ifndef PROBE_SUB
#define PROBE_SUB (-1)
#endif
#define SUBN(id) ((PROBE_SUB == (id)) ? 2 : 1)
#ifndef PROBE_REP
#define PROBE_REP (-1)
#endif

#define DI __device__ __forceinline__
#define LAS __attribute__((address_space(3)))
#define GAS __attribute__((address_space(1)))
typedef unsigned short bf16;
typedef unsigned char uchar;
typedef short bf16x8 __attribute__((ext_vector_type(8)));
typedef short s16x4 __attribute__((ext_vector_type(4)));
typedef float f32x4 __attribute__((ext_vector_type(4)));
typedef float f32x16 __attribute__((ext_vector_type(16)));
typedef unsigned u32x4 __attribute__((ext_vector_type(4)));
typedef unsigned u32x2 __attribute__((ext_vector_type(2)));
typedef float f32x2_t __attribute__((ext_vector_type(2)));
typedef __bf16 bf16x2_t __attribute__((ext_vector_type(2)));

constexpr int BATCH = 8, SEQ = 2048, DM = 1024, T = BATCH * SEQ, NIN = 4616, NMEM = 256, DMIX = 1536;
constexpr int LDP = 4608;
constexpr int CQ = 0, CK = 512, CV = 1024, CO = 1536, CU_ = 2048, CQC = 2560, CZA = 3072, CZB = 3584, CZC = 4096;
constexpr float EPS = 1e-6f, LOG2E = 1.4426950408889634f, KSCALE = 0.08838834764831845f;
constexpr int NPH = 10;

constexpr size_t WS_CTL = 0, CTL_ZERO_BYTES = 1u << 20;
constexpr int ROW_XB = 0, ROW_MEMN = T, ROW_WIN0 = T + 2048, WIN_ROWS = 4864, ROW_WKV0 = ROW_WIN0 + 2 * WIN_ROWS, WKV_ROWS = 1024, POOL_ROWS = ROW_WKV0 + 2 * WKV_ROWS;
constexpr size_t WS_POOL = 1u << 20;
constexpr size_t WS_PROJ = WS_POOL + (size_t)POOL_ROWS * 2048;
constexpr size_t WS_VT = WS_PROJ + (size_t)T * LDP * 2;
constexpr size_t WS_WOUT = WS_VT + (size_t)512 * T * 2;
constexpr size_t WS_KM = WS_WOUT + (size_t)2 * 1024 * 1536 * 2;
constexpr size_t WS_VMT = WS_KM + (size_t)2 * 2048 * 512 * 2;
constexpr size_t WS_KVT = WS_VMT + (size_t)2 * 512 * 2048 * 2;
constexpr size_t WS_NL = WS_KVT + (size_t)256 * 16384 * 2;
constexpr size_t WS_STS = WS_NL + (size_t)256 * 128 * 4;
constexpr size_t WS_SSQ = WS_STS + 4096;
constexpr size_t WS_GATES = WS_SSQ + (size_t)T * 16;
constexpr size_t WS_POOLW = WS_GATES + (size_t)T * 32;
constexpr size_t WS_END = WS_POOLW + (size_t)2 * 4 * 128 * 128 * 2;
static_assert(WS_END <= (size_t)256 * 1024 * 1024, "d_ws map exceeds 256 MiB");
constexpr int CW_TMO = 0, CW_BAR = 4096;

constexpr int L_RK = 0, L_RB = 69632, L_SC = 139264, MISC_OFF = 146432, LDS_BYTES = 147456;
constexpr int PA = 272, PB = 528;
constexpr int OSB = 16896, OSP = 132;

DI unsigned cvtpk(float lo, float hi) { f32x2_t v = {lo, hi}; bf16x2_t b = __builtin_convertvector(v, bf16x2_t); return __builtin_bit_cast(unsigned, b); }
DI u32x4 pack8(const float* f) { u32x4 r; r.x = cvtpk(f[0], f[1]); r.y = cvtpk(f[2], f[3]); r.z = cvtpk(f[4], f[5]); r.w = cvtpk(f[6], f[7]); return r; }
DI float bflo(unsigned u) { return __uint_as_float(u << 16); }
DI float bfhi(unsigned u) { return __uint_as_float(u & 0xffff0000u); }
DI void unpack8(u32x4 v, float* f) { f[0] = bflo(v.x); f[1] = bfhi(v.x); f[2] = bflo(v.y); f[3] = bfhi(v.y); f[4] = bflo(v.z); f[5] = bfhi(v.z); f[6] = bflo(v.w); f[7] = bfhi(v.w); }
DI float ex2(float x) { return __builtin_amdgcn_exp2f(x); }
DI float fexp(float x) { return __builtin_amdgcn_exp2f(x * LOG2E); }
DI float frcp(float x) { return __builtin_amdgcn_rcpf(x); }
DI float sigm(float x) { return frcp(1.f + fexp(-x)); }
DI float silu_f(float x) { return x * sigm(x); }
DI float logsig(float x) { return fminf(x, 0.f) - log1pf(__expf(-fabsf(x))); }
#define MFMA32(a, b, c) __builtin_amdgcn_mfma_f32_32x32x16_bf16((a), (b), (c), 0, 0, 0)

namespace pg8 {
#define PG8_LAS __attribute__((address_space(3)))
typedef unsigned short bf16_t;
constexpr int BM = 256, BK = 64, HALF = 128, HTB = HALF * BK * 2, STAGE_BYTES = 8 * HTB, NXCD = 8, WGM = 8;
__host__ __device__ __forceinline__ int lds_byte(int r, int c) { const int st = (r >> 4) * 2 + (c >> 5), rr = r & 15, cc = c & 31, ob = rr * 64 + cc * 2; return st * 1024 + (ob ^ (((ob >> 9) & 1) << 5)); }
__host__ __device__ __forceinline__ void stage_rc(int b, int& R, int& C) { const int st = b / 1024, sb = b % 1024, swz = sb ^ (((sb >> 9) & 1) << 5); R = (st >> 1) * 16 + swz / 64; C = (st & 1) * 32 + (swz % 64) / 2; }
__host__ __device__ __forceinline__ int perm32(int rho) { const int n = rho >> 4, i = rho & 15; return 8 * (i >> 2) + 4 * n + (i & 3); }

struct Unit { int arow, brow, kind, p0, p1, p2; };
struct Gemm { const bf16_t* A; const bf16_t* Bt; int lda, ldb, K; };

__device__ __forceinline__ void tile_of(int L, int nM, int nN, int& pm, int& pn) {
    const int nwg = nM * nN; int wgid = L; { const int q = nwg / NXCD, r = nwg % NXCD, xcd = wgid % NXCD, off = wgid / NXCD; wgid = (xcd < r ? xcd * (q + 1) : r * (q + 1) + (xcd - r) * q) + off; }
    const int nig = WGM * nN, gid = wgid / nig, fm = gid * WGM, gsz = (nM - fm) < WGM ? (nM - fm) : WGM;
    pm = fm + ((wgid % nig) % gsz); pn = (wgid % nig) / gsz;
}

template <class Epi, class Sched, bool ALIGN_EPI = false, bool SP2 = false>
__device__ __forceinline__ void gemm_phase(PG8_LAS unsigned char* lds, const Gemm g, const Sched& S, const Epi& E) {
    int tid_ = threadIdx.x; asm volatile("" : "+v"(tid_)); const int tid = tid_, wid = __builtin_amdgcn_readfirstlane(tid >> 6), lane = tid & 63, wr = wid >> 2, wc = wid & 3, fr = lane & 15, fq = lane >> 4;
    const int K = g.K, nt = K / BK;
    unsigned voffA[2], voffB[2];
#pragma unroll
    for (int i = 0; i < 2; ++i) { int R, C; stage_rc(tid * 16 + i * 8192, R, C); const int Rb = Epi::PERM ? ((R & ~31) + perm32(R & 31)) : R;
        voffA[i] = (unsigned)(R * g.lda + C) * 2u; voffB[i] = (unsigned)(Rb * g.ldb + C) * 2u; }
    const size_t kstep = (size_t)(BK * 2);
    const size_t hstepA = (size_t)HALF * g.lda * 2, hstepB = (size_t)HALF * g.ldb * 2;
    const unsigned ldsw = (unsigned)wid * 1024u;
    const int aoff = lds_byte(wr * 64 + fr, fq * 8), boff = lds_byte(wc * 32 + fr, fq * 8);
#define PG8_SA(b, h) (((b) * 2 + (h)) * HTB)
#define PG8_SB(b, h) ((4 + (b) * 2 + (h)) * HTB)
#define PG8_STAGE(bufoff, gbase, voff) do { _Pragma("unroll") for (int _i = 0; _i < 2; ++_i) \
        __builtin_amdgcn_global_load_lds((const unsigned*)((const char*)(gbase) + (voff)[_i]), (PG8_LAS unsigned*)(lds + (bufoff) + ldsw + _i * 8192), 16, 0, 0); } while (0)
#define PG8_LDA(dst, b, h) do { _Pragma("unroll") for (int m = 0; m < 4; ++m) _Pragma("unroll") for (int k = 0; k < 2; ++k) dst[m][k] = *(const PG8_LAS bf16x8*)(lds + PG8_SA(b, h) + aoff + m * 2048 + k * 1024); } while (0)
#define PG8_LDB(dst, b, h) do { _Pragma("unroll") for (int n = 0; n < 2; ++n) _Pragma("unroll") for (int k = 0; k < 2; ++k) dst[n][k] = *(const PG8_LAS bf16x8*)(lds + PG8_SB(b, h) + boff + n * 2048 + k * 1024); } while (0)
#define PG8_MMA(ai, bj, At, Bt) do { __builtin_amdgcn_s_setprio(1); _Pragma("unroll") for (int m = 0; m < 4; ++m) _Pragma("unroll") for (int n = 0; n < 2; ++n) _Pragma("unroll") for (int k = 0; k < 2; ++k) \
        acc[ai][bj][m][n] = __builtin_amdgcn_mfma_f32_16x16x32_bf16(Bt[n][k], At[m][k], acc[ai][bj][m][n], 0, 0, 0); __builtin_amdgcn_s_setprio(0); } while (0)
#define PG8_WAIT_V(n) asm volatile("s_waitcnt vmcnt(" #n ")" ::: "memory")
#define PG8_WAIT_L(n) asm volatile("s_waitcnt lgkmcnt(" #n ")" ::: "memory")
#define PG8_BAR __builtin_amdgcn_s_barrier()
#define PG8_SCHED __builtin_amdgcn_sched_barrier(0)
    Unit cur, nxt; int ui = 0;
    if (!S.next(0, cur)) return;
    f32x4 acc[2][2][4][2];
#pragma unroll
    for (int a = 0; a < 2; ++a)
#pragma unroll
        for (int b = 0; b < 2; ++b)
#pragma unroll
            for (int m = 0; m < 4; ++m)
#pragma unroll
                for (int n = 0; n < 2; ++n) acc[a][b][m][n] = (f32x4){0.f, 0.f, 0.f, 0.f};
    bf16x8 At[4][2], B0[2][2], B1[2][2];
    const char* cA = (const char*)g.A + (size_t)cur.arow * g.lda * 2; const char* cB = (const char*)g.Bt + (size_t)cur.brow * g.ldb * 2;
    if constexpr (SP2) {
        PG8_STAGE(PG8_SB(0, 0), cB, voffB); PG8_STAGE(PG8_SB(0, 1), cB + hstepB, voffB); PG8_STAGE(PG8_SA(0, 0), cA, voffA); PG8_STAGE(PG8_SA(0, 1), cA + hstepA, voffA);
        if (wr == 1) PG8_BAR;
        PG8_WAIT_V(2); PG8_BAR;
        PG8_STAGE(PG8_SB(1, 0), cB + kstep, voffB); PG8_STAGE(PG8_SA(1, 0), cA + kstep, voffA); PG8_STAGE(PG8_SB(1, 1), cB + hstepB + kstep, voffB);
        PG8_WAIT_V(6); PG8_BAR;
    } else {
        PG8_STAGE(PG8_SB(0, 0), cB, voffB); PG8_STAGE(PG8_SA(0, 0), cA, voffA); PG8_STAGE(PG8_SB(0, 1), cB + hstepB, voffB); PG8_STAGE(PG8_SA(0, 1), cA + hstepA, voffA);
        if (wr == 1) PG8_BAR;
        PG8_WAIT_V(4); PG8_BAR;
        PG8_STAGE(PG8_SB(1, 0), cB + kstep, voffB); PG8_STAGE(PG8_SA(1, 0), cA + kstep, voffA); PG8_STAGE(PG8_SB(1, 1), cB + hstepB + kstep, voffB);
        PG8_WAIT_V(6); PG8_BAR;
    }
    for (;;) {
        const bool has_next = S.next(ui + 1, nxt);
        const char* nA = has_next ? (const char*)g.A + (size_t)nxt.arow * g.lda * 2 : cA; const char* nB = has_next ? (const char*)g.Bt + (size_t)nxt.brow * g.ldb * 2 : cB;
        for (int t = 0; t < nt; t += 2) {
            const bool last = (t == nt - 2);
            const char* a1 = cA + (size_t)(t + 1) * kstep;
            const char* a2 = last ? nA : cA + (size_t)(t + 2) * kstep; const char* b2 = last ? nB : cB + (size_t)(t + 2) * kstep;
            const char* a3 = a2 + kstep; const char* b3 = b2 + kstep;
            if constexpr (SP2) {
            PG8_LDB(B0, 0, 0); PG8_LDB(B1, 0, 1); PG8_SCHED; PG8_LDA(At, 0, 0); PG8_STAGE(PG8_SA(1, 1), a1 + hstepA, voffA);
            PG8_WAIT_V(8); PG8_WAIT_L(0); PG8_BAR; PG8_MMA(0, 0, At, B0); PG8_MMA(0, 1, At, B1); PG8_BAR; PG8_SCHED;
            PG8_LDA(At, 0, 1); PG8_STAGE(PG8_SB(0, 0), b2, voffB); PG8_STAGE(PG8_SB(0, 1), b2 + hstepB, voffB); PG8_STAGE(PG8_SA(0, 0), a2, voffA);
            PG8_WAIT_V(8); PG8_WAIT_L(0); PG8_BAR; PG8_MMA(1, 0, At, B0); PG8_MMA(1, 1, At, B1); PG8_BAR; PG8_SCHED;
            PG8_LDB(B0, 1, 0); PG8_LDB(B1, 1, 1); PG8_SCHED; PG8_LDA(At, 1, 0); PG8_STAGE(PG8_SA(0, 1), a2 + hstepA, voffA);
            PG8_WAIT_V(8); PG8_WAIT_L(0); PG8_BAR; PG8_MMA(0, 0, At, B0); PG8_MMA(0, 1, At, B1); PG8_BAR; PG8_SCHED;
            PG8_LDA(At, 1, 1); PG8_STAGE(PG8_SB(1, 0), b3, voffB); PG8_STAGE(PG8_SB(1, 1), b3 + hstepB, voffB); PG8_STAGE(PG8_SA(1, 0), a3, voffA);
            PG8_WAIT_V(8); PG8_WAIT_L(0); PG8_BAR; PG8_MMA(1, 0, At, B0); PG8_MMA(1, 1, At, B1); PG8_BAR; PG8_SCHED;
            } else {
            PG8_LDB(B0, 0, 0); PG8_SCHED; PG8_LDA(At, 0, 0); PG8_STAGE(PG8_SA(1, 1), a1 + hstepA, voffA);
            PG8_WAIT_L(8); PG8_BAR; PG8_WAIT_L(0); PG8_MMA(0, 0, At, B0); PG8_BAR; PG8_SCHED;
            PG8_LDB(B1, 0, 1); PG8_STAGE(PG8_SB(0, 0), b2, voffB);
            PG8_BAR; PG8_WAIT_L(0); PG8_MMA(0, 1, At, B1); PG8_BAR;
            PG8_LDA(At, 0, 1); PG8_STAGE(PG8_SA(0, 0), a2, voffA);
            PG8_BAR; PG8_WAIT_L(0); PG8_MMA(1, 0, At, B0); PG8_BAR; PG8_SCHED;
            PG8_STAGE(PG8_SB(0, 1), b2 + hstepB, voffB);
            PG8_WAIT_V(6); PG8_BAR; PG8_MMA(1, 1, At, B1); PG8_BAR;
            PG8_LDB(B0, 1, 0); PG8_SCHED; PG8_LDA(At, 1, 0); PG8_STAGE(PG8_SA(0, 1), a2 + hstepA, voffA);
            PG8_WAIT_L(8); PG8_BAR; PG8_WAIT_L(0); PG8_MMA(0, 0, At, B0); PG8_BAR; PG8_SCHED;
            PG8_LDB(B1, 1, 1); PG8_STAGE(PG8_SB(1, 0), b3, voffB);
            PG8_BAR; PG8_WAIT_L(0); PG8_MMA(0, 1, At, B1); PG8_BAR;
            PG8_LDA(At, 1, 1); PG8_STAGE(PG8_SA(1, 0), a3, voffA);
            PG8_BAR; PG8_WAIT_L(0); PG8_MMA(1, 0, At, B0); PG8_BAR; PG8_SCHED;
            PG8_STAGE(PG8_SB(1, 1), b3 + hstepB, voffB);
            PG8_WAIT_V(6); PG8_BAR; PG8_MMA(1, 1, At, B1); PG8_BAR;
            }
        }
        if constexpr (ALIGN_EPI) { if (wr == 0) PG8_BAR; }
        if constexpr (!Epi::AFTER_DRAIN) { E(acc, cur, wr, wc, fr, fq); }
        if (!has_next) break;
#pragma unroll
        for (int a = 0; a < 2; ++a)
#pragma unroll
            for (int b = 0; b < 2; ++b)
#pragma unroll
                for (int m = 0; m < 4; ++m)
#pragma unroll
                    for (int n = 0; n < 2; ++n) acc[a][b][m][n] = (f32x4){0.f, 0.f, 0.f, 0.f};
        cur = nxt; cA = nA; cB = nB; ++ui;
        if constexpr (ALIGN_EPI) { if (wr == 1) PG8_BAR; }
    }
    PG8_WAIT_V(0);
    if constexpr (!ALIGN_EPI) { if (wr == 0) PG8_BAR; }
    PG8_BAR;
    if constexpr (Epi::AFTER_DRAIN) { E.fused(acc, cur, wr, wc, fr, fq, lds, wid, lane); }
#undef PG8_SA
#undef PG8_SB
#undef PG8_STAGE
#undef PG8_LDA
#undef PG8_LDB
#undef PG8_MMA
#undef PG8_WAIT_V
#undef PG8_WAIT_L
#undef PG8_BAR
#undef PG8_SCHED
}
}

struct G1Order {
    int G, c, layer, with_mem;
    DI bool next(int i, pg8::Unit& u) const {
        int L = i * G + c;
        if (L < 64 * 19) {
            int pm, pn; pg8::tile_of(L, 64, 19, pm, pn);
            const int wrow = ROW_WIN0 + layer * WIN_ROWS + pn * 256, xrow = ROW_XB + pm * 256;
            if (pn == 4 || pn == 5) { u.kind = 1; u.arow = wrow; u.brow = xrow; }
            else { u.kind = (pn == 18) ? 2 : 0; u.arow = xrow; u.brow = wrow; }
            u.p0 = pm; u.p1 = pn; u.p2 = layer; return true;
        }
        L -= 64 * 19;
        if (!with_mem || L >= 64) return false;
        const int l = L >> 5; int r = L & 31;
        if (r < 16) { const int mt = r >> 1, nt = r & 1; u.kind = 3; u.arow = ROW_MEMN + mt * 256; u.brow = ROW_WKV0 + l * WKV_ROWS + nt * 256; u.p0 = mt; u.p1 = nt; u.p2 = l; }
        else { r -= 16; const int nt = r >> 3, mt = r & 7; u.kind = 4; u.arow = ROW_WKV0 + l * WKV_ROWS + 512 + nt * 256; u.brow = ROW_MEMN + mt * 256; u.p0 = nt; u.p1 = mt; u.p2 = l; }
        return true;
    }
};
struct EpiG1 {
    static constexpr bool PERM = true, AFTER_DRAIN = false;
    bf16* proj; bf16* vt; float* gates; const float* ssq; const float* bg; bf16* km; bf16* vmt;
    DI float rstd_of(int row) const { const f32x4 s = *(const f32x4*)(ssq + (size_t)row * 4); return rsqrtf(((s.x + s.y) + (s.z + s.w)) * (1.0f / DM) + EPS); }
    DI void operator()(const f32x4 (&acc)[2][2][4][2], const pg8::Unit& u, int wr, int wc, int fr, int fq) const {
        const int kind = u.kind, rowl = wr * 64 + fr, coll = wc * 32 + 8 * fq;
        if (kind == 0 || kind == 2) {
#pragma unroll
            for (int ai = 0; ai < 2; ++ai)
#pragma unroll
                for (int m = 0; m < 4; ++m) {
                    const int row = u.p0 * 256 + ai * 128 + m * 16 + rowl; const float rs = rstd_of(row);
                    if (kind == 0) {
#pragma unroll
                        for (int bj = 0; bj < 2; ++bj) { const f32x4 v0 = acc[ai][bj][m][0] * rs, v1 = acc[ai][bj][m][1] * rs;
                            u32x4 w; w.x = cvtpk(v0[0], v0[1]); w.y = cvtpk(v0[2], v0[3]); w.z = cvtpk(v1[0], v1[1]); w.w = cvtpk(v1[2], v1[3]);
                            *(u32x4*)(proj + (size_t)row * LDP + u.p1 * 256 + bj * 128 + coll) = w; }
                    } else if (wc == 0 && fq == 0) {
                        const f32x4 b0 = *(const f32x4*)(bg), b1 = *(const f32x4*)(bg + 4);
                        *(f32x4*)(gates + (size_t)row * 8) = acc[ai][0][m][0] * rs + b0; *(f32x4*)(gates + (size_t)row * 8 + 4) = acc[ai][0][m][1] * rs + b1;
                    }
                }
        } else if (kind == 1) {
#pragma unroll
            for (int bj = 0; bj < 2; ++bj) {
                const int tok0 = u.p0 * 256 + bj * 128 + coll; f32x4 r0, r1;
#pragma unroll
                for (int q = 0; q < 4; ++q) { r0[q] = rstd_of(tok0 + q); r1[q] = rstd_of(tok0 + 4 + q); }
#pragma unroll
                for (int ai = 0; ai < 2; ++ai)
#pragma unroll
                    for (int m = 0; m < 4; ++m) { const int n = (u.p1 - 4) * 256 + ai * 128 + m * 16 + rowl; const f32x4 v0 = acc[ai][bj][m][0] * r0, v1 = acc[ai][bj][m][1] * r1;
                        u32x4 w; w.x = cvtpk(v0[0], v0[1]); w.y = cvtpk(v0[2], v0[3]); w.z = cvtpk(v1[0], v1[1]); w.w = cvtpk(v1[2], v1[3]);
                        *(u32x4*)(vt + (size_t)n * T + tok0) = w; }
            }
        } else {
            bf16* base = (kind == 3) ? km + (size_t)u.p2 * 2048 * 512 : vmt + (size_t)u.p2 * 512 * 2048; const int ld = (kind == 3) ? 512 : 2048;
#pragma unroll
            for (int ai = 0; ai < 2; ++ai)
#pragma unroll
                for (int m = 0; m < 4; ++m) { const int row = u.p0 * 256 + ai * 128 + m * 16 + rowl;
#pragma unroll
                    for (int bj = 0; bj < 2; ++bj) { const f32x4 v0 = acc[ai][bj][m][0], v1 = acc[ai][bj][m][1];
                        u32x4 w; w.x = cvtpk(v0[0], v0[1]); w.y = cvtpk(v0[2], v0[3]); w.z = cvtpk(v1[0], v1[1]); w.w = cvtpk(v1[2], v1[3]);
                        *(u32x4*)(base + (size_t)row * ld + u.p1 * 256 + bj * 128 + coll) = w; } }
        }
    }
};
struct G2Order { int G, c; DI bool next(int i, pg8::Unit& u) const { const int L = i * G + c; if (L >= 256) return false; int pm, pn; pg8::tile_of(L, 64, 4, pm, pn); u.kind = 0; u.arow = pm * 256; u.brow = pn * 256; u.p0 = pm; u.p1 = pn; u.p2 = 0; return true; } };
struct EpiG2 {
    static constexpr bool PERM = true, AFTER_DRAIN = true;
    const float* base; float* out; bf16* xb; float* ssq;
    DI void fused(f32x4 (&acc)[2][2][4][2], const pg8::Unit& u, int wr, int wc, int fr, int fq, LAS uchar* lds, int wid, int lane) const {
        LAS float* Pp = (LAS float*)lds;
        const size_t coff = (size_t)u.p1 * 256 + wc * 32 + 8 * fq;
        f32x4 bs[4][2][2];
#pragma unroll
        for (int ai = 0; ai < 2; ++ai) {
#pragma unroll
            for (int m = 0; m < 4; ++m) { const size_t roff = (size_t)(u.p0 * 256 + ai * 128 + wr * 64 + m * 16 + fr) * DM + coff;
#pragma unroll
                for (int bj = 0; bj < 2; ++bj) { bs[m][bj][0] = *(const f32x4*)(base + roff + bj * 128); bs[m][bj][1] = *(const f32x4*)(base + roff + bj * 128 + 4); } }
            asm volatile("" ::: "memory");
#pragma unroll
            for (int m = 0; m < 4; ++m) {
                const int rl = ai * 128 + wr * 64 + m * 16 + fr; const size_t roff = (size_t)(u.p0 * 256 + rl) * DM + coff; float ss = 0.f;
#pragma unroll
                for (int bj = 0; bj < 2; ++bj) { const size_t off = roff + bj * 128;
                    const f32x4 v0 = acc[ai][bj][m][0] + bs[m][bj][0], v1 = acc[ai][bj][m][1] + bs[m][bj][1];
                    *(f32x4*)(out + off) = v0; *(f32x4*)(out + off + 4) = v1;
                    u32x4 w; w.x = cvtpk(v0[0], v0[1]); w.y = cvtpk(v0[2], v0[3]); w.z = cvtpk(v1[0], v1[1]); w.w = cvtpk(v1[2], v1[3]);
                    *(u32x4*)(xb + off) = w;
                    ss += (v0[0] * v0[0] + v0[1] * v0[1]) + (v0[2] * v0[2] + v0[3] * v0[3]) + (v1[0] * v1[0] + v1[1] * v1[1]) + (v1[2] * v1[2] + v1[3] * v1[3]); }
                ss += __shfl_xor(ss, 16); ss += __shfl_xor(ss, 32);
                if (fq == 0) Pp[rl * 4 + wc] = ss;
            }
            asm volatile("" ::: "memory");
        }
        __syncthreads();
        const int tid = wid * 64 + lane;
        if (tid < 256) { const f32x4 p = *(LAS f32x4*)(Pp + tid * 4); ssq[(size_t)(u.p0 * 256 + tid) * 4 + u.p1] = (p.x + p.y) + (p.z + p.w); }
    }
};

#define XB_TMO      128
#define XB_XCNT(j)  (256  + 64 * (j))
#define XB_XSUB(j)  (1280 + 64 * (j))
#define XB_XGEN(j)  (2304 + 64 * (j))
#define XB_TOP      3328
#define XB_TOPGEN   3392
#define XCD_BAR_WORDS 3456
#define XB_SPIN_CAP (1u << 18)
__device__ __forceinline__ unsigned xb_ld(unsigned* p)              { return __hip_atomic_load(p, __ATOMIC_RELAXED, __HIP_MEMORY_SCOPE_AGENT); }
__device__ __forceinline__ unsigned xb_add(unsigned* p, unsigned v) { return __hip_atomic_fetch_add(p, v, __ATOMIC_RELAXED, __HIP_MEMORY_SCOPE_AGENT); }
__device__ __forceinline__ unsigned xb_xcc_id() { return (unsigned)__builtin_amdgcn_s_getreg((3 << 11) | 20) & 0xFu; }
#define XB_SPIN(cond, bar) do { unsigned _sp = 0; while (cond) { __builtin_amdgcn_s_sleep(1); \
    if ((++_sp & 255u) == 0u) { if (xb_ld(&(bar)[XB_TMO])) break; if (_sp > XB_SPIN_CAP) { atomicAdd(&(bar)[XB_TMO], 1u); break; } } } } while (0)
struct XcdBarrier { unsigned* bar; unsigned x; volatile LAS unsigned* st; };
__device__ __forceinline__ XcdBarrier xcd_barrier_post(unsigned* bar, volatile LAS unsigned* st) {
    XcdBarrier b; b.bar = bar; b.x = xb_xcc_id(); b.st = st;
    if (threadIdx.x == 0) (void)xb_add(&bar[XB_XCNT(b.x)], 1u);
    return b;
}
__device__ __forceinline__ void xcd_barrier_complete(unsigned* bar, unsigned x, unsigned& nloc, unsigned& nx) {
    const unsigned G = gridDim.x * gridDim.y * gridDim.z;
    unsigned sum, cnt, mine, sp = 0u;
    for (;;) {
        sum = 0u; cnt = 0u; mine = 0u;
#pragma unroll
        for (unsigned j = 0; j < 16; ++j) { const unsigned c = xb_ld(&bar[XB_XCNT(j)]); sum += c; cnt += (c > 0u) ? 1u : 0u; mine = (j == x) ? c : mine; }
        if (sum == G) break;
        __builtin_amdgcn_s_sleep(1);
        if ((++sp & 255u) == 0u) { if (xb_ld(&bar[XB_TMO])) break; if (sp > XB_SPIN_CAP) { atomicAdd(&bar[XB_TMO], 1u); break; } }
    }
    nloc = mine > 0u ? mine : 1u; nx = cnt > 0u ? cnt : 1u;
}
__device__ __forceinline__ void xcd_barrier(const XcdBarrier& b) {
    asm volatile("s_waitcnt vmcnt(0)" ::: "memory");
    __syncthreads();
    if (threadIdx.x == 0) {
        unsigned* bar = b.bar;
        __builtin_amdgcn_s_waitcnt(0);
        unsigned nloc = b.st[0], nx = b.st[1];
        if (nloc == 0u) { xcd_barrier_complete(bar, b.x, nloc, nx); b.st[0] = nloc; b.st[1] = nx; }
        const unsigned old = xb_add(&bar[XB_XSUB(b.x)], 1u);
        const unsigned gen = old / nloc;
        if (old + 1u == (gen + 1u) * nloc) {
            __builtin_amdgcn_fence(__ATOMIC_RELEASE, "agent");
            asm volatile("s_waitcnt vmcnt(0)" ::: "memory");
            const unsigned og = xb_add(&bar[XB_TOP], 1u);
            const unsigned tg = og / nx;
            if (og + 1u == (tg + 1u) * nx) xb_add(&bar[XB_TOPGEN], 1u);
            else XB_SPIN(xb_ld(&bar[XB_TOPGEN]) == tg, bar);
            __builtin_amdgcn_fence(__ATOMIC_ACQUIRE, "agent");
            xb_add(&bar[XB_XGEN(b.x)], 1u);
            asm volatile("s_waitcnt vmcnt(0)" ::: "memory");
        } else {
            XB_SPIN(xb_ld(&bar[XB_XGEN(b.x)]) == gen, bar);
            __builtin_amdgcn_fence(__ATOMIC_ACQUIRE, "agent");
            asm volatile("s_waitcnt vmcnt(0)" ::: "memory");
        }
    }
    __syncthreads();
}

struct Args { const float* in[14]; float* out; uchar* ws; int ph_lo, ph_hi, li, pad; };
struct Ctx {
    LAS uchar* lds; int tid, lane, wave, G, vcu;
    const float *x, *mem, *norm_g, *w_in, *b_gates, *conv_w, *conv_b, *mng, *pool_w, *pool_scale, *mem_norm_g, *w_mem_kv, *w_out, *fng;
    float* out; bf16 *pool, *proj, *vt, *wout, *km, *vmt, *kvt, *poolw; float *nl, *sts, *ssq, *gates;
};

DI float wave_sum(float v) {
#pragma unroll
    for (int o = 1; o < 64; o <<= 1) v += __shfl_xor(v, o);
    return v;
}
DI int srccol_win(int n) {
    if (n < 2048) return n;
    if (n < 2560) return 2568 + (n - 2048);
    if (n < 3072) return 3592 + (n - 2560);
    if (n < 3584) return 2048 + (n - 3072);
    if (n < 4096) return 3080 + (n - 3584);
    if (n < 4608) return 4104 + (n - 4096);
    if (n < 4616) return 2560 + (n - 4608);
    return -1;
}
template <bool WINMAP>
DI void tr_item(const float* W, int ldw, const float* gsc, bf16* WT, int K, int k0, int n0, LAS float* scr, int lane) {
    const int nn = n0 + (lane & 31); const int sc = WINMAP ? srccol_win(nn) : nn;
#pragma unroll 8
    for (int i = 0; i < 32; ++i) { const int kk = 2 * i + (lane >> 5); float v = 0.f; if (sc >= 0) { v = W[(size_t)(k0 + kk) * ldw + sc]; if (gsc) v *= gsc[k0 + kk]; } scr[kk * 33 + (lane & 31)] = v; }
    asm volatile("s_waitcnt lgkmcnt(0)" ::: "memory");
    const int c = lane & 7;
#pragma unroll
    for (int j = 0; j < 4; ++j) { const int n = (lane >> 3) + 8 * j; const LAS float* s = scr + (8 * c) * 33 + n;
        u32x4 o; o.x = cvtpk(s[0 * 33], s[1 * 33]); o.y = cvtpk(s[2 * 33], s[3 * 33]); o.z = cvtpk(s[4 * 33], s[5 * 33]); o.w = cvtpk(s[6 * 33], s[7 * 33]);
        *(u32x4*)(WT + (size_t)(n0 + n) * K + k0 + 8 * c) = o; }
    asm volatile("s_waitcnt lgkmcnt(0)" ::: "memory");
}
DI void p0_prologue(const Ctx& F) {
    LAS float* scr = (LAS float*)(F.lds + F.wave * 16384);
    int lane_ = F.lane; asm volatile("" : "+v"(lane_)); const int gw = F.vcu * 8 + F.wave, NGW = F.G * 8, lane = lane_;
    constexpr int I_WIN = 16 * (WIN_ROWS / 32), I_WKV = 16 * 32, I_WOUT = 24 * 32, I_PW = 4 * 8, I_L = I_WIN + I_WKV + I_WOUT + I_PW;
    for (int it = gw; it < 2 * I_L; it += NGW) {
        const int l = it / I_L; int r = it % I_L;
        if (r < I_WIN) { const int kb = r / (WIN_ROWS / 32), nb = r % (WIN_ROWS / 32); tr_item<true>(F.w_in + (size_t)l * DM * NIN, NIN, F.norm_g + l * DM, F.pool + (size_t)(ROW_WIN0 + l * WIN_ROWS) * DM, DM, 64 * kb, 32 * nb, scr, lane); continue; } r -= I_WIN;
        if (r < I_WKV) { const int kb = r / 32, nb = r % 32; tr_item<false>(F.w_mem_kv + (size_t)l * DM * 1024, 1024, F.mem_norm_g + l * DM, F.pool + (size_t)(ROW_WKV0 + l * WKV_ROWS) * DM, DM, 64 * kb, 32 * nb, scr, lane); continue; } r -= I_WKV;
        if (r < I_WOUT) { const int kb = r / 32, nb = r % 32; tr_item<false>(F.w_out + (size_t)l * DMIX * DM, DM, nullptr, F.wout + (size_t)l * DM * DMIX, DMIX, 64 * kb, 32 * nb, scr, lane); continue; } r -= I_WOUT;
        { const int g = r >> 3, kb = (r >> 2) & 1, nb = r & 3; tr_item<false>(F.pool_w + (size_t)(l * 4 + g) * 16384, 128, nullptr, F.poolw + (size_t)(l * 4 + g) * 16384, 128, 64 * kb, 32 * nb, scr, lane); }
    }
    for (int m = gw; m < T + BATCH * NMEM; m += NGW) {
        const bool isx = m < T; const float* src = isx ? F.x + (size_t)m * DM : F.mem + (size_t)(m - T) * DM;
        const f32x4* xr = (const f32x4*)src + lane; f32x4 v[4]; float s = 0.f;
#pragma unroll
        for (int j = 0; j < 4; ++j) { v[j] = xr[64 * j]; s += (v[j].x * v[j].x + v[j].y * v[j].y) + (v[j].z * v[j].z + v[j].w * v[j].w); }
        s = wave_sum(s);
        float sc = 1.f;
        if (isx) { if (lane == 0) *(f32x4*)(F.ssq + (size_t)m * 4) = (f32x4){s, 0.f, 0.f, 0.f}; } else sc = rsqrtf(s * (1.0f / DM) + EPS);
        u32x2* o8 = (u32x2*)(F.pool + (size_t)(isx ? ROW_XB + m : ROW_MEMN + (m - T)) * DM) + lane;
#pragma unroll
        for (int j = 0; j < 4; ++j) { u32x2 w; w.x = cvtpk(v[j].x * sc, v[j].y * sc); w.y = cvtpk(v[j].z * sc, v[j].w * sc); o8[64 * j] = w; }
    }
}

DI int crow(int i, int h) { return (i & 3) + 8 * (i >> 2) + 4 * h; }
DI float wave_scan_add(float v, int lane) {
#pragma unroll
    for (int o = 1; o < 64; o <<= 1) { const float t = __shfl_up(v, o); if (lane >= o) v += t; }
    return v;
}
DI float wave_scan_max(float v, int lane) {
#pragma unroll
    for (int o = 1; o < 64; o <<= 1) { const float t = __shfl_up(v, o); if (lane >= o) v = fmaxf(v, t); }
    return v;
}
DI float block_scan_add(float v, LAS float* tmp, int wid, int lane, float& total) {
    float inc = wave_scan_add(v, lane);
    if (lane == 63 && wid < 4) tmp[wid] = inc;
    __syncthreads();
    const float t0 = tmp[0], t1 = tmp[1], t2 = tmp[2], t3 = tmp[3];
    inc += (wid > 0 ? t0 : 0.f) + (wid > 1 ? t1 : 0.f) + (wid > 2 ? t2 : 0.f);
    total = ((t0 + t1) + t2) + t3;
    __syncthreads();
    return inc;
}
DI float block_scan_max(float v, LAS float* tmp, int wid, int lane, float& total) {
    float inc = wave_scan_max(v, lane);
    if (lane == 63 && wid < 4) tmp[wid] = inc;
    __syncthreads();
    const float t0 = tmp[0], t1 = tmp[1], t2 = tmp[2], t3 = tmp[3];
    if (wid > 0) inc = fmaxf(inc, t0); if (wid > 1) inc = fmaxf(inc, t1); if (wid > 2) inc = fmaxf(inc, t2);
    total = fmaxf(fmaxf(t0, t1), fmaxf(t2, t3));
    __syncthreads();
    return inc;
}
DI void conv_block(const bf16* src, const float* cw, const float* cb, int R0, int tseq0, int tid, float (&o)[8][8]) {
    const int t8 = tid >> 4, d8 = tid & 15;
    u32x4 raw[11];
#pragma unroll
    for (int j = 0; j < 11; ++j) { const int tr = t8 * 8 - 3 + j; raw[j] = (u32x4){0u, 0u, 0u, 0u}; if (tseq0 + tr >= 0) raw[j] = *(const u32x4*)(src + (size_t)(R0 + tr) * LDP + d8 * 8); }
    float w[4][8], bb[8];
#pragma unroll
    for (int j = 0; j < 4; ++j) { const f32x4 a = *(const f32x4*)(cw + j * 1024 + d8 * 8), b = *(const f32x4*)(cw + j * 1024 + d8 * 8 + 4);
        w[j][0] = a.x; w[j][1] = a.y; w[j][2] = a.z; w[j][3] = a.w; w[j][4] = b.x; w[j][5] = b.y; w[j][6] = b.z; w[j][7] = b.w; }
    { const f32x4 a = *(const f32x4*)(cb + d8 * 8), b = *(const f32x4*)(cb + d8 * 8 + 4); bb[0] = a.x; bb[1] = a.y; bb[2] = a.z; bb[3] = a.w; bb[4] = b.x; bb[5] = b.y; bb[6] = b.z; bb[7] = b.w; }
#pragma unroll
    for (int t = 0; t < 8; ++t) {
        float a[8];
#pragma unroll
        for (int i = 0; i < 8; ++i) a[i] = bb[i];
#pragma unroll
        for (int j = 0; j < 4; ++j) { float x[8]; unpack8(raw[t + j], x);
#pragma unroll
            for (int i = 0; i < 8; ++i) a[i] += w[j][i] * x[i]; }
#pragma unroll
        for (int i = 0; i < 8; ++i) o[t][i] = silu_f(a[i]);
    }
}
DI void stage_vt(const bf16* vt, int h, int R0, LAS uchar* dst, int tid) {
    const int e = tid >> 2, part = tid & 3;
    const u32x4* src = (const u32x4*)(vt + (size_t)(h * 128 + e) * T + R0 + part * 64);
    u32x4 v[8];
#pragma unroll
    for (int i = 0; i < 8; ++i) v[i] = src[i];
#pragma unroll
    for (int i = 0; i < 8; ++i) *(LAS u32x4*)(dst + e * PB + part * 128 + i * 16) = v[i];
}
DI void stage_O(const f32x16 (&O)[4], LAS float* OS, int r, int hh) {
#pragma unroll
    for (int dt = 0; dt < 4; ++dt)
#pragma unroll
        for (int i = 0; i < 16; ++i) OS[crow(i, hh) * OSP + 32 * dt + r] = O[dt][i];
}

DI void mlstm_state_unit(const Ctx& F, int l, int unit) {
    const int bh = unit / 7, c = unit % 7, b = bh >> 2, h = bh & 3, R0 = b * SEQ + c * 256;
    int tid_ = F.tid; asm volatile("" : "+v"(tid_)); const int tid = tid_, lane = tid & 63, w = __builtin_amdgcn_readfirstlane(tid >> 6), r = lane & 31, hh = lane >> 5;
    LAS uchar* lds = F.lds; LAS float* SC = (LAS float*)(lds + L_SC); LAS float* WT_ = SC; LAS float* TMP = SC + 1408;
    float ig = 0.f, lf = 0.f;
    if (tid < 256) { const float* gp = F.gates + (size_t)(R0 + tid) * 8; ig = gp[h]; lf = logsig(gp[4 + h]); }
    float bL; const float bt = block_scan_add(lf, TMP, w, lane, bL);
    const float g = (tid < 256) ? (bL - bt + ig) : -INFINITY;
    float gmax; (void)block_scan_max(g, TMP, w, lane, gmax);
    if (tid < 256) WT_[tid] = fexp(g - gmax);
    if (tid == 0) { F.sts[(bh * 8 + c) * 2] = bL; F.sts[(bh * 8 + c) * 2 + 1] = gmax; }
    __syncthreads();
    {
        float o[8][8]; conv_block(F.proj + CK + h * 128, F.conv_w + (size_t)l * 4096 + 512 + h * 128, F.conv_b + l * 1024 + 512 + h * 128, R0, c * 256, tid, o);
        const int t8 = tid >> 4, d8 = tid & 15; float wt[8];
#pragma unroll
        for (int t = 0; t < 8; ++t) wt[t] = WT_[t8 * 8 + t] * KSCALE;
#pragma unroll
        for (int i = 0; i < 8; ++i) { float col[8];
#pragma unroll
            for (int t = 0; t < 8; ++t) col[t] = o[t][i] * wt[t];
            *(LAS u32x4*)(lds + L_RK + (d8 * 8 + i) * PB + t8 * 16) = pack8(col); }
    }
    stage_vt(F.vt, h, R0, lds + L_RB, tid);
    __syncthreads();
    {
        const int et = w >> 1, dt0 = (w & 1) * 2; f32x16 acc2[2];
#pragma unroll
        for (int n = 0; n < 2; ++n)
#pragma unroll
            for (int i = 0; i < 16; ++i) acc2[n][i] = 0.f;
#pragma unroll 4
        for (int ks = 0; ks < 16; ++ks) { const bf16x8 a = *(LAS const bf16x8*)(lds + L_RB + (32 * et + r) * PB + (16 * ks + 8 * hh) * 2);
#pragma unroll
            for (int n = 0; n < 2; ++n) { const bf16x8 bb = *(LAS const bf16x8*)(lds + L_RK + (32 * (dt0 + n) + r) * PB + (16 * ks + 8 * hh) * 2); acc2[n] = MFMA32(a, bb, acc2[n]); } }
        bf16* dst = F.kvt + (size_t)(bh * 8 + c) * 16384;
#pragma unroll
        for (int n = 0; n < 2; ++n)
#pragma unroll
            for (int i = 0; i < 16; ++i) dst[(32 * et + crow(i, hh)) * 128 + 32 * (dt0 + n) + r] = (bf16)(cvtpk(acc2[n][i], 0.f) & 0xffffu);
        const int d = tid >> 2, part = tid & 3; float s = 0.f;
#pragma unroll
        for (int q = 0; q < 8; ++q) { float x[8]; unpack8(*(LAS const u32x4*)(lds + L_RK + d * PB + part * 128 + q * 16), x); s += ((x[0] + x[1]) + (x[2] + x[3])) + ((x[4] + x[5]) + (x[6] + x[7])); }
        s += __shfl_xor(s, 1); s += __shfl_xor(s, 2);
        if (part == 0) F.nl[(bh * 8 + c) * 128 + d] = s;
    }
    __syncthreads();
}

DI void prefetch_rows(const bf16* base, int lane, u32x4 (&raw)[8]) {
#pragma unroll
    for (int idx = 0; idx < 8; ++idx) raw[idx] = *(const u32x4*)(base + (size_t)(8 * (idx >> 1) + (lane >> 3)) * LDP + 64 * (idx & 1) + 8 * (lane & 7));
}
DI void finalize_simple(LAS const float* OS, int lane, LAS const float* rowscale, const float* colscale, bf16* zbase, int zo, const u32x4 (&zraw)[8]) {
#pragma unroll
    for (int idx = 0; idx < 8; ++idx) {
        const int row = 8 * (idx >> 1) + (lane >> 3), c0 = 64 * (idx & 1) + 8 * (lane & 7); float zz[8], y[8];
        unpack8(zraw[idx], zz);
        const f32x4 o0 = *(LAS const f32x4*)(OS + row * OSP + c0), o1 = *(LAS const f32x4*)(OS + row * OSP + c0 + 4);
        const float rs = rowscale ? rowscale[row] : 1.0f;
        f32x4 s0 = (f32x4){1.f, 1.f, 1.f, 1.f}, s1 = s0; if (colscale) { s0 = *(const f32x4*)(colscale + c0); s1 = *(const f32x4*)(colscale + c0 + 4); }
#pragma unroll
        for (int j = 0; j < 4; ++j) { y[j] = o0[j] * rs * s0[j] * silu_f(zz[j]); y[4 + j] = o1[j] * rs * s1[j] * silu_f(zz[4 + j]); }
        *(u32x4*)(zbase + (size_t)row * LDP + zo + c0) = pack8(y);
    }
}

template <int WIN>
DI void pool_ptile(const Ctx& F, int R0, int tseq0, int g, LAS uchar* dst, int tid) {
    const int t8 = tid >> 4, c8 = tid & 15; constexpr int NR = 8 + WIN - 1;
    u32x4 raw[NR];
#pragma unroll
    for (int j = 0; j < NR; ++j) { const int tr = t8 * 8 - (WIN - 1) + j; raw[j] = (u32x4){0u, 0u, 0u, 0u}; if (tseq0 + tr >= 0) raw[j] = *(const u32x4*)(F.proj + (size_t)(R0 + tr) * LDP + CU_ + g * 128 + c8 * 8); }
    float s[8];
#pragma unroll
    for (int i = 0; i < 8; ++i) s[i] = 0.f;
#pragma unroll
    for (int j = 0; j < WIN; ++j) { float x[8]; unpack8(raw[j], x);
#pragma unroll
        for (int i = 0; i < 8; ++i) s[i] += x[i]; }
#pragma unroll
    for (int t = 0; t < 8; ++t) {
        float cur[8]; unpack8(raw[t + WIN - 1], cur);
        const int tq = tseq0 + t8 * 8 + t; const float inv = 1.0f / (float)((tq + 1 < WIN) ? (tq + 1) : WIN);
        float p[8];
#pragma unroll
        for (int i = 0; i < 8; ++i) p[i] = s[i] * inv - cur[i];
        *(LAS u32x4*)(dst + (t8 * 8 + t) * PA + c8 * 16) = pack8(p);
        if (t < 7) { float xo[8], xn[8]; unpack8(raw[t], xo); unpack8(raw[t + WIN], xn);
#pragma unroll
            for (int i = 0; i < 8; ++i) s[i] += xn[i] - xo[i]; }
    }
}
DI void pool_unit(const Ctx& F, int l, int unit, int zo) {
    const int g = unit & 3, tt = (unit >> 2) & 7, b = unit >> 5, R0 = b * SEQ + tt * 256;
    int tid_ = F.tid; asm volatile("" : "+v"(tid_)); const int tid = tid_, lane = tid & 63, w = __builtin_amdgcn_readfirstlane(tid >> 6), r = lane & 31, hh = lane >> 5;
    LAS uchar* lds = F.lds;
    for (int rp = 0; rp < SUBN(31); ++rp) {
    if (g == 0) pool_ptile<2>(F, R0, tt * 256, g, lds + L_RK, tid); else if (g == 1) pool_ptile<4>(F, R0, tt * 256, g, lds + L_RK, tid);
    else if (g == 2) pool_ptile<8>(F, R0, tt * 256, g, lds + L_RK, tid); else pool_ptile<16>(F, R0, tt * 256, g, lds + L_RK, tid);
    { const u32x4* src = (const u32x4*)(F.poolw + (size_t)(l * 4 + g) * 16384);
#pragma unroll
      for (int i = 0; i < 4; ++i) { const int id = tid + 512 * i; *(LAS u32x4*)(lds + L_RB + (id >> 4) * PA + (id & 15) * 16) = src[id]; } }
    __syncthreads();
    }
    f32x16 O[4];
    bf16* zbase = F.proj + (size_t)(R0 + 32 * w) * LDP + CZB + g * 128; u32x4 zraw[8]; prefetch_rows(zbase, lane, zraw);
    for (int rp = 0; rp < SUBN(32); ++rp) {
#pragma unroll
    for (int dt = 0; dt < 4; ++dt)
#pragma unroll
        for (int i = 0; i < 16; ++i) O[dt][i] = 0.f;
#pragma unroll
    for (int kc = 0; kc < 8; ++kc) { const bf16x8 a = *(LAS const bf16x8*)(lds + L_RK + (32 * w + r) * PA + (16 * kc + 8 * hh) * 2);
#pragma unroll
        for (int dt = 0; dt < 4; ++dt) { const bf16x8 bb = *(LAS const bf16x8*)(lds + L_RB + (32 * dt + r) * PA + (16 * kc + 8 * hh) * 2); O[dt] = MFMA32(a, bb, O[dt]); } }
    }
    __syncthreads();
    LAS float* OS = (LAS float*)(lds + w * OSB);
    for (int rp = 0; rp < SUBN(33); ++rp) {
    stage_O(O, OS, r, hh);
    __syncthreads();
    }
    for (int rp = 0; rp < SUBN(34); ++rp)
    finalize_simple(OS, lane, nullptr, F.pool_scale + l * 512 + g * 128, zbase, (rp + 1 < SUBN(34)) ? (CV - CZB) : zo, zraw);
    __syncthreads();
}

DI void attn_unit(const Ctx& F, int l, int unit, int zo) {
    const int tt = unit & 7, h = (unit >> 3) & 3, b = unit >> 5, R0 = b * SEQ + tt * 256;
    int tid_ = F.tid; asm volatile("" : "+v"(tid_)); const int tid = tid_, lane = tid & 63, w = __builtin_amdgcn_readfirstlane(tid >> 6), r = lane & 31, hh = lane >> 5;
    LAS uchar* lds = F.lds; LAS float* DEN = (LAS float*)(lds + L_SC) + 1024;
    bf16x8 qf[8];
    for (int rp = 0; rp < SUBN(41); ++rp) {
    { const bf16* kmb = F.km + (size_t)l * 2048 * 512 + (size_t)(b * 256) * 512 + h * 128;
#pragma unroll
      for (int i = 0; i < 8; ++i) { const int id = tid + 512 * i, m = id >> 4, c8 = id & 15; *(LAS u32x4*)(lds + L_RK + m * PA + c8 * 16) = *(const u32x4*)(kmb + (size_t)m * 512 + c8 * 8); }
      const bf16* vmb = F.vmt + (size_t)l * 512 * 2048 + (size_t)(h * 128) * 2048 + b * 256;
#pragma unroll
      for (int i = 0; i < 8; ++i) { const int id = tid + 512 * i, d = id >> 5, c = id & 31; *(LAS u32x4*)(lds + L_RB + d * PB + c * 16) = *(const u32x4*)(vmb + (size_t)d * 2048 + c * 8); } }
    { const bf16* qrow = F.proj + (size_t)(R0 + 32 * w + r) * LDP + CQC + h * 128 + 8 * hh;
#pragma unroll
      for (int kd = 0; kd < 8; ++kd) qf[kd] = *(const bf16x8*)(qrow + 16 * kd); }
    __syncthreads();
    }
    f32x16 O[4];
    bf16* zbase = F.proj + (size_t)(R0 + 32 * w) * LDP + CZC + h * 128; u32x4 zraw[8];
    for (int rp = 0; rp < SUBN(42); ++rp) {
    f32x16 X[8];
#pragma unroll
    for (int mt = 0; mt < 8; ++mt) {
#pragma unroll
        for (int i = 0; i < 16; ++i) X[mt][i] = 0.f;
#pragma unroll
        for (int kd = 0; kd < 8; ++kd) { const bf16x8 a = *(LAS const bf16x8*)(lds + L_RK + (32 * mt + r) * PA + (16 * kd + 8 * hh) * 2); X[mt] = MFMA32(a, qf[kd], X[mt]); }
    }
    float mx = -INFINITY;
#pragma unroll
    for (int mt = 0; mt < 8; ++mt)
#pragma unroll
        for (int i = 0; i < 16; ++i) mx = fmaxf(mx, X[mt][i]);
    mx = fmaxf(mx, __shfl_xor(mx, 32));
    const float sc2 = KSCALE * LOG2E, mb = mx * sc2; float lsum = 0.f;
    bf16x8 pa[8][2];
#pragma unroll
    for (int mt = 0; mt < 8; ++mt) { float p[16];
#pragma unroll
        for (int i = 0; i < 16; ++i) { p[i] = ex2(X[mt][i] * sc2 - mb); lsum += p[i]; }
        pa[mt][0] = __builtin_bit_cast(bf16x8, pack8(p)); pa[mt][1] = __builtin_bit_cast(bf16x8, pack8(p + 8)); }
    lsum += __shfl_xor(lsum, 32);
    prefetch_rows(zbase, lane, zraw);
#pragma unroll
    for (int dt = 0; dt < 4; ++dt)
#pragma unroll
        for (int i = 0; i < 16; ++i) O[dt][i] = 0.f;
#pragma unroll
    for (int mt = 0; mt < 8; ++mt)
#pragma unroll
        for (int s = 0; s < 2; ++s)
#pragma unroll
            for (int dt = 0; dt < 4; ++dt) {
                const LAS uchar* vp = lds + L_RB + (32 * dt + r) * PB + (32 * mt + 16 * s + 4 * hh) * 2;
                const s16x4 lo = *(LAS const s16x4*)vp, hi = *(LAS const s16x4*)(vp + 16);
                O[dt] = MFMA32(pa[mt][s], __builtin_shufflevector(lo, hi, 0, 1, 2, 3, 4, 5, 6, 7), O[dt]); }
    if (hh == 0) DEN[32 * w + r] = frcp(lsum);
    }
    __syncthreads();
    LAS float* OS = (LAS float*)(lds + w * OSB);
    stage_O(O, OS, r, hh);
    __syncthreads();
    for (int rp = 0; rp < SUBN(44); ++rp)
    finalize_simple(OS, lane, DEN + 32 * w, nullptr, zbase, (rp + 1 < SUBN(44)) ? (CV - CZC) : zo, zraw);
    __syncthreads();
}

DI void mlstm_out_unit(const Ctx& F, int l, int unit, int zo) {
    const int bh = unit >> 3, c = unit & 7, b = bh >> 2, h = bh & 3, R0 = b * SEQ + c * 256;
    int tid_ = F.tid; asm volatile("" : "+v"(tid_)); const int tid = tid_, lane = tid & 63, w = __builtin_amdgcn_readfirstlane(tid >> 6), r = lane & 31, hh = lane >> 5;
    LAS uchar* lds = F.lds; LAS float* SC = (LAS float*)(lds + L_SC);
    LAS float *GS2 = SC, *R2 = SC + 256, *AT = SC + 512, *EM = SC + 768, *DEN = SC + 1024, *NP = SC + 1280, *TMP = SC + 1408;
    float ig = 0.f, lf = 0.f;
    if (tid < 256) { const float* gp = F.gates + (size_t)(R0 + tid) * 8; ig = gp[h]; lf = logsig(gp[4 + h]); }
    float btot; const float bt = block_scan_add(lf, TMP, w, lane, btot);
    const float gs = (tid < 256) ? (ig - bt) : -INFINITY;
    float coef[7]; float mprev = -INFINITY;
    { float lc[7]; float acc = 0.f;
#pragma unroll
      for (int cp = 6; cp >= 0; --cp) { lc[cp] = -INFINITY; if (cp < c) { const float bl = F.sts[(bh * 8 + cp) * 2], gm = F.sts[(bh * 8 + cp) * 2 + 1]; lc[cp] = gm + acc; acc += bl; mprev = fmaxf(mprev, lc[cp]); } }
#pragma unroll
      for (int cp = 0; cp < 7; ++cp) coef[cp] = (cp < c) ? fexp(lc[cp] - mprev) : 0.f; }
    float cmt; const float cm = block_scan_max(gs, TMP, w, lane, cmt);
    if (tid < 256) { const float rt = fmaxf(mprev, cm); GS2[tid] = gs * LOG2E; R2[tid] = rt * LOG2E; AT[tid] = (c > 0) ? fexp(mprev - rt) : 0.f; EM[tid] = fexp(-(bt + rt)); }
    { float a[4][8];
#pragma unroll
      for (int i = 0; i < 4; ++i)
#pragma unroll
          for (int j = 0; j < 8; ++j) a[i][j] = 0.f;
#pragma unroll
      for (int cp = 0; cp < 7; ++cp) if (cp < c) { const u32x4* sp = (const u32x4*)(F.kvt + (size_t)(bh * 8 + cp) * 16384); const float cf = coef[cp];
#pragma unroll
          for (int i = 0; i < 4; ++i) { float x[8]; unpack8(sp[tid + 512 * i], x);
#pragma unroll
              for (int j = 0; j < 8; ++j) a[i][j] += cf * x[j]; } }
#pragma unroll
      for (int i = 0; i < 4; ++i) { const int idx = (tid + 512 * i) * 8; *(LAS u32x4*)(lds + L_RB + (idx >> 7) * PA + (idx & 127) * 2) = pack8(a[i]); }
      if (tid < 128) { float s = 0.f;
#pragma unroll
          for (int cp = 0; cp < 7; ++cp) if (cp < c) s += coef[cp] * F.nl[(bh * 8 + cp) * 128 + tid];
          NP[tid] = s; } }
    { float o[8][8]; conv_block(F.proj + CQ + h * 128, F.conv_w + (size_t)l * 4096 + h * 128, F.conv_b + l * 1024 + h * 128, R0, c * 256, tid, o);
      const int t8 = tid >> 4, d8 = tid & 15;
#pragma unroll
      for (int t = 0; t < 8; ++t) *(LAS u32x4*)(lds + L_RK + (t8 * 8 + t) * PA + d8 * 16) = pack8(o[t]); }
    __syncthreads();
    bf16x8 qf[8]; float qn = 0.f;
#pragma unroll
    for (int kd = 0; kd < 8; ++kd) { qf[kd] = *(LAS const bf16x8*)(lds + L_RK + (32 * w + r) * PA + (16 * kd + 8 * hh) * 2);
        float x[8]; unpack8(__builtin_bit_cast(u32x4, qf[kd]), x); const f32x4 n0 = *(LAS const f32x4*)(NP + 16 * kd + 8 * hh), n1 = *(LAS const f32x4*)(NP + 16 * kd + 8 * hh + 4);
        qn += (x[0] * n0[0] + x[1] * n0[1]) + (x[2] * n0[2] + x[3] * n0[3]) + (x[4] * n1[0] + x[5] * n1[1]) + (x[6] * n1[2] + x[7] * n1[3]); }
    qn += __shfl_xor(qn, 32);
    f32x16 O[4];
#pragma unroll
    for (int et = 0; et < 4; ++et)
#pragma unroll
        for (int i = 0; i < 16; ++i) O[et][i] = 0.f;
    if (c > 0) {
#pragma unroll
        for (int kd = 0; kd < 8; ++kd)
#pragma unroll
            for (int et = 0; et < 4; ++et) { const bf16x8 cb = *(LAS const bf16x8*)(lds + L_RB + (32 * et + r) * PA + (16 * kd + 8 * hh) * 2); O[et] = MFMA32(qf[kd], cb, O[et]); }
#pragma unroll
        for (int g = 0; g < 4; ++g) { const f32x4 av = *(LAS const f32x4*)(AT + 32 * w + 8 * g + 4 * hh);
#pragma unroll
            for (int et = 0; et < 4; ++et)
#pragma unroll
                for (int j = 0; j < 4; ++j) O[et][4 * g + j] *= av[j]; }
    }
    __syncthreads();
    { float o[8][8]; conv_block(F.proj + CK + h * 128, F.conv_w + (size_t)l * 4096 + 512 + h * 128, F.conv_b + l * 1024 + 512 + h * 128, R0, c * 256, tid, o);
      const int t8 = tid >> 4, d8 = tid & 15;
#pragma unroll
      for (int t = 0; t < 8; ++t) { float kk[8];
#pragma unroll
          for (int i = 0; i < 8; ++i) kk[i] = o[t][i] * KSCALE;
          *(LAS u32x4*)(lds + L_RK + (t8 * 8 + t) * PA + d8 * 16) = pack8(kk); } }
    stage_vt(F.vt, h, R0, lds + L_RB, tid);
    __syncthreads();
    const float r2 = R2[32 * w + r]; float den = 0.f;
    bf16* zbase = F.proj + (size_t)(R0 + 32 * w) * LDP + CZA + h * 128; u32x4 ograw[8], zraw[8];
    prefetch_rows(zbase + (CO - CZA), lane, ograw); prefetch_rows(zbase, lane, zraw);
    for (int j = 0; j <= w; ++j) {
        const int s0 = 32 * j; f32x16 X;
#pragma unroll
        for (int i = 0; i < 16; ++i) X[i] = 0.f;
#pragma unroll
        for (int kd = 0; kd < 8; ++kd) { const bf16x8 a = *(LAS const bf16x8*)(lds + L_RK + (s0 + r) * PA + (16 * kd + 8 * hh) * 2); X = MFMA32(a, qf[kd], X); }
        float p[16];
#pragma unroll
        for (int g = 0; g < 4; ++g) { const f32x4 gv = *(LAS const f32x4*)(GS2 + s0 + 8 * g + 4 * hh);
#pragma unroll
            for (int jj = 0; jj < 4; ++jj) { float val = ex2(gv[jj] - r2) * X[4 * g + jj]; if (j == w && (8 * g + 4 * hh + jj) > r) val = 0.f; p[4 * g + jj] = val; den += val; } }
        const bf16x8 pa0 = __builtin_bit_cast(bf16x8, pack8(p)), pa1 = __builtin_bit_cast(bf16x8, pack8(p + 8));
#pragma unroll
        for (int s = 0; s < 2; ++s)
#pragma unroll
            for (int et = 0; et < 4; ++et) {
                const LAS uchar* vp = lds + L_RB + (32 * et + r) * PB + (s0 + 16 * s + 4 * hh) * 2;
                const s16x4 lo = *(LAS const s16x4*)vp, hi = *(LAS const s16x4*)(vp + 16);
                O[et] = MFMA32(s ? pa1 : pa0, __builtin_shufflevector(lo, hi, 0, 1, 2, 3, 4, 5, 6, 7), O[et]); }
    }
    den += __shfl_xor(den, 32);
    if (hh == 0) { const int t = 32 * w + r; const float dt_ = AT[t] * qn + den; DEN[t] = frcp(fmaxf(fabsf(dt_), EM[t])); }
    __syncthreads();
    LAS float* OS = (LAS float*)(lds + w * OSB);
    stage_O(O, OS, r, hh);
    __syncthreads();
    {
        float hv[64]; float ss[4] = {0.f, 0.f, 0.f, 0.f};
#pragma unroll
        for (int idx = 0; idx < 8; ++idx) { const int row = 8 * (idx >> 1) + (lane >> 3), c0 = 64 * (idx & 1) + 8 * (lane & 7); float og[8]; unpack8(ograw[idx], og);
            const float inv = DEN[32 * w + row];
            const f32x4 o0 = *(LAS const f32x4*)(OS + row * OSP + c0), o1 = *(LAS const f32x4*)(OS + row * OSP + c0 + 4);
#pragma unroll
            for (int j = 0; j < 4; ++j) { const float v0 = o0[j] * inv * sigm(og[j]), v1 = o1[j] * inv * sigm(og[4 + j]); hv[idx * 8 + j] = v0; hv[idx * 8 + 4 + j] = v1; ss[idx >> 1] += v0 * v0 + v1 * v1; } }
        const float* ng = F.mng + l * 512 + h * 128;
#pragma unroll
        for (int k = 0; k < 4; ++k) { float s_ = ss[k]; s_ += __shfl_xor(s_, 1); s_ += __shfl_xor(s_, 2); s_ += __shfl_xor(s_, 4); ss[k] = rsqrtf(s_ * (1.0f / 128.0f) + EPS); }
#pragma unroll
        for (int idx = 0; idx < 8; ++idx) { const int row = 8 * (idx >> 1) + (lane >> 3), c0 = 64 * (idx & 1) + 8 * (lane & 7); float zz[8], y[8]; unpack8(zraw[idx], zz);
            const f32x4 g0 = *(const f32x4*)(ng + c0), g1 = *(const f32x4*)(ng + c0 + 4); const float rn = ss[idx >> 1];
#pragma unroll
            for (int j = 0; j < 4; ++j) { y[j] = hv[idx * 8 + j] * rn * g0[j] * silu_f(zz[j]); y[4 + j] = hv[idx * 8 + 4 + j] * rn * g1[j] * silu_f(zz[4 + j]); }
            *(u32x4*)(zbase + (size_t)row * LDP + zo + c0) = pack8(y); }
    }
    __syncthreads();
}

DI void final_norm(const Ctx& F) {
    int lane_ = F.lane; asm volatile("" : "+v"(lane_)); const int gw = F.vcu * 8 + F.wave, NGW = F.G * 8, lane = lane_;
    f32x4 g[4];
#pragma unroll
    for (int j = 0; j < 4; ++j) g[j] = ((const f32x4*)F.fng)[lane + 64 * j];
    for (int m = gw; m < T; m += NGW) {
        const f32x4 s = *(const f32x4*)(F.ssq + (size_t)m * 4); const float rs = rsqrtf(((s.x + s.y) + (s.z + s.w)) * (1.0f / DM) + EPS);
        f32x4* xr = (f32x4*)(F.out + (size_t)m * DM) + lane;
#pragma unroll
        for (int j = 0; j < 4; ++j) xr[64 * j] = xr[64 * j] * rs * g[j];
    }
}

__global__ void __launch_bounds__(512, 2) hybrid_fwd(Args args) {
    extern __shared__ __attribute__((aligned(16))) unsigned char lds_raw[];
    Ctx F;
    F.lds = (LAS uchar*)lds_raw; F.tid = threadIdx.x; F.lane = F.tid & 63; F.wave = __builtin_amdgcn_readfirstlane(F.tid >> 6);
    F.G = gridDim.x; { const int bx = blockIdx.x; F.vcu = (F.G % 8 == 0) ? (bx % 8) * (F.G / 8) + bx / 8 : bx; }
    uchar* ws = args.ws;
    F.x = args.in[0]; F.mem = args.in[1]; F.norm_g = args.in[2]; F.w_in = args.in[3]; F.b_gates = args.in[4]; F.conv_w = args.in[5]; F.conv_b = args.in[6]; F.mng = args.in[7];
    F.pool_w = args.in[8]; F.pool_scale = args.in[9]; F.mem_norm_g = args.in[10]; F.w_mem_kv = args.in[11]; F.w_out = args.in[12]; F.fng = args.in[13]; F.out = args.out;
    F.pool = (bf16*)(ws + WS_POOL); F.proj = (bf16*)(ws + WS_PROJ); F.vt = (bf16*)(ws + WS_VT); F.wout = (bf16*)(ws + WS_WOUT); F.km = (bf16*)(ws + WS_KM); F.vmt = (bf16*)(ws + WS_VMT);
    F.kvt = (bf16*)(ws + WS_KVT); F.poolw = (bf16*)(ws + WS_POOLW); F.nl = (float*)(ws + WS_NL); F.sts = (float*)(ws + WS_STS); F.ssq = (float*)(ws + WS_SSQ); F.gates = (float*)(ws + WS_GATES);
    volatile LAS unsigned* MISC = (volatile LAS unsigned*)(F.lds + MISC_OFF);
    for (int u = F.tid; u < (LDS_BYTES - MISC_OFF) / 4; u += 512) MISC[u] = 0u;
    __syncthreads();
    unsigned* ctl = (unsigned*)(ws + WS_CTL);
    XcdBarrier bar; bar.bar = ctl + CW_BAR; bar.x = 0; bar.st = nullptr;
    if (MK_N_LAUNCHES == 1) bar = xcd_barrier_post(ctl + CW_BAR, MISC + 8);
    const int lo = args.ph_lo, hi = args.ph_hi;
#define IN(k) (lo <= (k) && (k) < hi)
#define SEAM(k) do { if (IN(k) && IN((k) + 1)) xcd_barrier(bar); } while (0)

#define NREP(id) ((PROBE_REP == (id)) ? 2 : 1)
#define REPBAR(id, rep) do { if ((rep) + 1 < NREP(id)) xcd_barrier(bar); } while (0)
    if (IN(0)) { for (int rep = 0; rep < NREP(0); ++rep) { p0_prologue(F); REPBAR(0, rep); } } SEAM(0);
#pragma unroll 1
    for (int l = 0; l < 2; ++l) {
        const int pb = 1 + 4 * l;
        if (IN(pb)) {
            for (int rep = 0; rep < NREP(1); ++rep) {
            pg8::Gemm g{F.pool, F.pool, DM, DM, DM}; G1Order S{F.G, (int)blockIdx.x, l, l == 0 ? 1 : 0};
            EpiG1 E{F.proj, F.vt, F.gates, F.ssq, F.b_gates + l * 8, F.km, F.vmt};
            pg8::gemm_phase<EpiG1, G1Order, true, true>(F.lds, g, S, E);
            REPBAR(1, rep); }
        } SEAM(pb);
        if (IN(pb + 1)) {
            const int u = (int)blockIdx.x;
            for (int rep = 0; rep < NREP(2); ++rep) { for (int i = u; i < 224; i += F.G) mlstm_state_unit(F, l, i); REPBAR(2, rep); }
        } SEAM(pb + 1);
        if (IN(pb + 2)) {
            const int u = (int)blockIdx.x, rot = (u >> 3) % 3;
            for (int step = 0; step < 3; ++step) {
                const int ty = (step + rot) % 3;
                if (ty == 0) { for (int rep = 0; rep < NREP(5); ++rep) { for (int i = u; i < 256; i += F.G) mlstm_out_unit(F, l, i, (rep + 1 < NREP(5)) ? (CV - CZA) : 0); REPBAR(5, rep); } }
                else if (ty == 1) { for (int rep = 0; rep < NREP(3); ++rep) { for (int i = u; i < 256; i += F.G) pool_unit(F, l, i, (rep + 1 < NREP(3)) ? (CV - CZB) : 0); REPBAR(3, rep); } }
                else { for (int rep = 0; rep < NREP(4); ++rep) { for (int i = u; i < 256; i += F.G) attn_unit(F, l, i, (rep + 1 < NREP(4)) ? (CV - CZC) : 0); REPBAR(4, rep); } }
            }
        } SEAM(pb + 2);
        if (IN(pb + 3)) {
            for (int rep = 0; rep < ((l == 0) ? NREP(6) : 1); ++rep) {
            pg8::Gemm g{F.proj + CZA, F.wout + (size_t)l * DM * DMIX, LDP, DMIX, DMIX}; G2Order S{F.G, (int)blockIdx.x};
            EpiG2 E{l == 0 ? F.x : F.out, F.out, F.pool + (size_t)ROW_XB * DM, F.ssq};
            pg8::gemm_phase<EpiG2, G2Order, false, true>(F.lds, g, S, E);
            if (l == 0) REPBAR(6, rep); }
        } SEAM(pb + 3);
    }
    if (IN(9)) final_norm(F);
#undef IN
#undef SEAM
}

extern "C" void kernel_launch(void* const* d_in, const int* in_sizes, int n_in, void* d_out, int out_size, void* d_ws, size_t ws_size, hipStream_t stream) {
    static int grid = 0;
    if (grid == 0) {
        if (n_in != 14 || in_sizes[0] != T * DM || out_size != T * DM || ws_size < WS_END) { fprintf(stderr, "kernel_launch: unexpected shapes (n_in %d, in0 %d, out %d, ws %zu); nothing launched\n", n_in, n_in > 0 ? in_sizes[0] : -1, out_size, ws_size); grid = -1; return; }
        int dev = 0, cus = 0;
        if (hipGetDevice(&dev) != hipSuccess || hipDeviceGetAttribute(&cus, hipDeviceAttributeMultiprocessorCount, dev) != hipSuccess) { grid = -1; return; }
        if (hipFuncSetAttribute((const void*)hybrid_fwd, hipFuncAttributeMaxDynamicSharedMemorySize, LDS_BYTES) != hipSuccess) { fprintf(stderr, "kernel_launch: hipFuncSetAttribute failed\n"); grid = -1; return; }
        int per_cu = 0;
        if (hipOccupancyMaxActiveBlocksPerMultiprocessor(&per_cu, (const void*)hybrid_fwd, 512, LDS_BYTES) != hipSuccess || per_cu < 1) fprintf(stderr, "kernel_launch: occupancy query reports %d blocks per CU\n", per_cu);
        (void)hipGetLastError();
        grid = cus;
    }
    if (grid < 0) return;
    if (hipMemsetAsync((char*)d_ws + WS_CTL, 0, CTL_ZERO_BYTES, stream) != hipSuccess) return;
    Args a{};
    for (int i = 0; i < 14; ++i) a.in[i] = (const float*)d_in[i];
    a.out = (float*)d_out; a.ws = (uchar*)d_ws;
    for (int li = 0; li < MK_N_LAUNCHES; ++li) {
        if (MK_N_LAUNCHES == 1) { a.ph_lo = 0; a.ph_hi = NPH; } else { a.ph_lo = li * NPH / MK_N_LAUNCHES; a.ph_hi = (li + 1) * NPH / MK_N_LAUNCHES; }
        a.li = li;
        hipLaunchKernelGGL(hybrid_fwd, dim3(grid), dim3(512), LDS_BYTES, stream, a);
        const hipError_t le = hipPeekAtLastError();
        if (le != hipSuccess) { fprintf(stderr, "kernel_launch: launch %d failed: %s\n", li, hipGetErrorName(le)); break; }
    }
}
```
